# Optimizing an MI355X kernel written in HIP

```python
import math
import jax, jax.numpy as jnp
from jax import lax
import numpy as np

D_MODEL = 1024
BATCH = 8
SEQ = 2048
DEPTH = 4

MEM_LEN = 256
DIFF_HEADS = 8
DIFF_HEAD_DIM = 64
DIFF_WIDTH = DIFF_HEADS * 2 * DIFF_HEAD_DIM
Q_BLOCK = 128
RET_HEADS = 4
RET_KEY_DIM = 128
RET_VAL_DIM = 256
RET_QK_WIDTH = RET_HEADS * RET_KEY_DIM
RET_WIDTH = RET_HEADS * RET_VAL_DIM
RET_CHUNK = 128
LRU_WIDTH = D_MODEL
LRU_BLOCKS = 8
LRU_BLOCK_W = LRU_WIDTH // LRU_BLOCKS
CONV_WIDTH = 4
LRU_C = 8.0
N_BRANCH = 3
XA_HEADS = 4
XA_HEAD_DIM = 128
XA_WIDTH = XA_HEADS * XA_HEAD_DIM
D_FF = 4 * D_MODEL
IN_WIDTHS = (DIFF_WIDTH, DIFF_WIDTH, DIFF_WIDTH, RET_QK_WIDTH, RET_QK_WIDTH, RET_WIDTH, RET_WIDTH, LRU_WIDTH, LRU_WIDTH, N_BRANCH * D_MODEL)
IN_COLS = 3 * DIFF_WIDTH + 2 * RET_QK_WIDTH + 2 * RET_WIDTH + 2 * LRU_WIDTH + N_BRANCH * D_MODEL

kernel_name = 'hybrid_diffattn_retention_rglru_gated'


def _split_points():
    pts, acc = [], 0
    for w in IN_WIDTHS[:-1]:
        acc += w
        pts.append(acc)
    return pts


def rmsnorm(x, g, eps=1e-6):
    xf = x.astype(jnp.float32)
    y = xf * lax.rsqrt(jnp.mean(xf * xf, axis=-1, keepdims=True) + eps)
    return (y * g.astype(jnp.float32)).astype(x.dtype)


def group_norm_heads(o, eps=1e-5):
    mu = jnp.mean(o, axis=-1, keepdims=True)
    var = jnp.mean(jnp.square(o - mu), axis=-1, keepdims=True)
    return (o - mu) * lax.rsqrt(var + eps)


def rotate_every_two(t):
    t1 = t[..., 0::2]
    t2 = t[..., 1::2]
    return jnp.stack((-t2, t1), axis=-1).reshape(t.shape)


def diff_attention(q, k, v, lam):
    bn, s_len = q.shape[0], q.shape[1]
    nb = s_len // Q_BLOCK
    qb = q.reshape(bn, nb, Q_BLOCK, DIFF_HEADS, 2, DIFF_HEAD_DIM).swapaxes(0, 1)
    starts = jnp.arange(nb, dtype=jnp.int32) * Q_BLOCK
    kpos = jnp.arange(s_len, dtype=jnp.int32)
    scale = DIFF_HEAD_DIM ** -0.5

    def block(args):
        q_blk, start = args
        s = jnp.einsum('bqhcd,bkhcd->bhcqk', q_blk, k).astype(jnp.float32) * scale
        qpos = start + jnp.arange(Q_BLOCK, dtype=jnp.int32)
        causal = kpos[None, :] <= qpos[:, None]
        s = jnp.where(causal, s, -jnp.inf)
        p = jax.nn.softmax(s, axis=-1)
        a = p[:, :, 0] - lam * p[:, :, 1]
        return jnp.einsum('bhqk,bkhe->bqhe', a.astype(v.dtype), v)

    o = lax.map(block, (qb, starts))
    return o.swapaxes(0, 1).reshape(bn, s_len, DIFF_HEADS, 2 * DIFF_HEAD_DIM)


def retention_chunkwise(q, k, v, log_g):
    bn, s_len = q.shape[0], q.shape[1]
    n_chunks = s_len // RET_CHUNK

    def chunk(t):
        return t.reshape(bn, n_chunks, RET_CHUNK, RET_HEADS, t.shape[-1]).transpose(0, 3, 1, 2, 4)

    q, k, v = chunk(q), chunk(k), chunk(v)
    idx = jnp.arange(RET_CHUNK, dtype=jnp.float32)
    rel = idx[:, None] - idx[None, :]
    decay = jnp.where(rel[None] >= 0, jnp.exp(jnp.maximum(rel, 0.0)[None] * log_g[:, None, None]), 0.0)
    s = jnp.einsum('bhncd,bhnmd->bhncm', q, k) * decay[:, None]
    o_intra = jnp.einsum('bhncm,bhnme->bhnce', s, v)
    w_k = jnp.exp((RET_CHUNK - 1 - idx)[None, :] * log_g[:, None])
    kv = jnp.einsum('bhncd,hc,bhnce->bhnde', k, w_k, v)
    chunk_decay = jnp.exp(RET_CHUNK * log_g)[None, :, None, None]

    def step(state, kv_n):
        return chunk_decay * state + kv_n, state

    init = jnp.zeros((bn, RET_HEADS, RET_KEY_DIM, RET_VAL_DIM), jnp.float32)
    _, prev = lax.scan(step, init, jnp.moveaxis(kv, 2, 0))
    prev = jnp.moveaxis(prev, 0, 2)
    w_q = jnp.exp((idx + 1.0)[None, :] * log_g[:, None])
    o_cross = jnp.einsum('bhncd,bhnde->bhnce', q, prev) * w_q[None, :, None, :, None]
    o = o_intra + o_cross
    return o.transpose(0, 2, 3, 1, 4).reshape(bn, s_len, RET_HEADS, RET_VAL_DIM)


def rg_lru_branch(xb, conv_w, conv_b, w_a, b_a, w_x, b_x, lam):
    bn, s_len, width = xb.shape
    xc = lax.conv_general_dilated(xb, conv_w.astype(xb.dtype), window_strides=(1,), padding=[(CONV_WIDTH - 1, 0)], dimension_numbers=('NWC', 'WIO', 'NWC'), feature_group_count=width) + conv_b
    xg = xc.reshape(bn, s_len, LRU_BLOCKS, LRU_BLOCK_W)
    r = jax.nn.sigmoid(jnp.einsum('bsnc,ncd->bsnd', xg, w_a).reshape(bn, s_len, width) + b_a)
    i = jax.nn.sigmoid(jnp.einsum('bsnc,ncd->bsnd', xg, w_x).reshape(bn, s_len, width) + b_x)
    log_a = -LRU_C * r.astype(jnp.float32) * jax.nn.softplus(-lam.astype(jnp.float32))
    a = jnp.exp(log_a)
    mult = jnp.sqrt(-jnp.expm1(2.0 * log_a))
    b = mult * (i * xc).astype(jnp.float32)

    def combine(lhs, rhs):
        a1, b1 = lhs
        a2, b2 = rhs
        return a1 * a2, a2 * b1 + b2

    _, h = lax.associative_scan(combine, (a, b), axis=1)
    return h.astype(xb.dtype)


def setup_inputs(seed: int = 0) -> dict:
    key = jax.random.key(seed)
    ks = jax.random.split(key, 32)
    f32 = jnp.float32

    def nrm(k, shape, fan_in):
        return jax.random.normal(k, shape, f32) * fan_in ** -0.5

    def gain(k, shape):
        return 1.0 + 0.01 * jax.random.normal(k, shape, f32)

    def small(k, shape, scale=0.01):
        return scale * jax.random.normal(k, shape, f32)

    u = jax.random.uniform(ks[14], (DEPTH, LRU_WIDTH), f32, minval=0.81, maxval=0.998)
    sa = jnp.sqrt(u)
    lru_lambda = jnp.log(sa) - jnp.log1p(-sa)
    return {
        'x': jax.random.normal(ks[0], (BATCH, SEQ, D_MODEL), f32),
        'mem': jax.random.normal(ks[1], (BATCH, MEM_LEN, D_MODEL), f32),
        'norm_mix': gain(ks[2], (DEPTH, D_MODEL)),
        'w_in': nrm(ks[3], (DEPTH, D_MODEL, IN_COLS), D_MODEL),
        'diff_lq1': small(ks[4], (DEPTH, DIFF_HEAD_DIM), 0.1),
        'diff_lk1': small(ks[5], (DEPTH, DIFF_HEAD_DIM), 0.1),
        'diff_lq2': small(ks[6], (DEPTH, DIFF_HEAD_DIM), 0.1),
        'diff_lk2': small(ks[7], (DEPTH, DIFF_HEAD_DIM), 0.1),
        'diff_subln': gain(ks[8], (DEPTH, 2 * DIFF_HEAD_DIM)),
        'lru_conv_w': nrm(ks[9], (DEPTH, CONV_WIDTH, 1, LRU_WIDTH), CONV_WIDTH),
        'lru_conv_b': small(ks[10], (DEPTH, LRU_WIDTH)),
        'lru_wa': nrm(ks[11], (DEPTH, LRU_BLOCKS, LRU_BLOCK_W, LRU_BLOCK_W), LRU_BLOCK_W),
        'lru_ba': small(ks[12], (DEPTH, LRU_WIDTH)),
        'lru_wx': nrm(ks[13], (DEPTH, LRU_BLOCKS, LRU_BLOCK_W, LRU_BLOCK_W), LRU_BLOCK_W),
        'lru_bx': small(ks[15], (DEPTH, LRU_WIDTH)),
        'lru_lambda': lru_lambda,
        'w_branch': nrm(ks[16], (DEPTH, N_BRANCH, DIFF_WIDTH, D_MODEL), DIFF_WIDTH),
        'w_out': nrm(ks[17], (DEPTH, D_MODEL, D_MODEL), D_MODEL),
        'norm_xattn': gain(ks[18], (DEPTH, D_MODEL)),
        'norm_mem': gain(ks[19], (DEPTH, D_MODEL)),
        'xa_wq': nrm(ks[20], (DEPTH, D_MODEL, XA_WIDTH), D_MODEL),
        'xa_wkv': nrm(ks[21], (DEPTH, D_MODEL, 2 * XA_WIDTH), D_MODEL),
        'xa_wo': nrm(ks[22], (DEPTH, XA_WIDTH, D_MODEL), XA_WIDTH),
        'norm_mlp': gain(ks[23], (DEPTH, D_MODEL)),
        'mlp_w1': nrm(ks[24], (DEPTH, D_MODEL, D_FF), D_MODEL),
        'mlp_w2': nrm(ks[25], (DEPTH, D_FF, D_MODEL), D_FF),
        'norm_final': gain(ks[26], (D_MODEL,)),
    }


def reference(x, mem, norm_mix, w_in, diff_lq1, diff_lk1, diff_lq2, diff_lk2, diff_subln, lru_conv_w, lru_conv_b, lru_wa, lru_ba, lru_wx, lru_bx, lru_lambda, w_branch, w_out, norm_xattn, norm_mem, xa_wq, xa_wkv, xa_wo, norm_mlp, mlp_w1, mlp_w2, norm_final):
    f32 = jnp.float32
    bn, s_len, _ = x.shape
    m_len = mem.shape[1]
    splits = _split_points()
    pos = jnp.arange(s_len, dtype=f32)
    angle = jnp.repeat(1.0 / (10000.0 ** jnp.linspace(0.0, 1.0, RET_KEY_DIM // 2, dtype=f32)), 2)
    phase = pos[:, None] * angle[None, :]
    cos = jnp.cos(phase)[None, :, None, :]
    sin = jnp.sin(phase)[None, :, None, :]
    log_g = jnp.log(1.0 - jnp.exp2(-5.0 - jnp.arange(RET_HEADS, dtype=f32)))

    for l in range(DEPTH):
        h = rmsnorm(x, norm_mix[l])
        u = h @ w_in[l]
        dq, dk, dv, rq, rk, rv, rg, lx, ly, gates = jnp.split(u, splits, axis=-1)

        lam_init = 0.8 - 0.6 * math.exp(-0.3 * l)
        lam = (jnp.exp(jnp.sum(diff_lq1[l].astype(f32) * diff_lk1[l].astype(f32)))
               - jnp.exp(jnp.sum(diff_lq2[l].astype(f32) * diff_lk2[l].astype(f32))) + lam_init)
        od = diff_attention(dq.reshape(bn, s_len, DIFF_HEADS, 2, DIFF_HEAD_DIM),
                            dk.reshape(bn, s_len, DIFF_HEADS, 2, DIFF_HEAD_DIM),
                            dv.reshape(bn, s_len, DIFF_HEADS, 2 * DIFF_HEAD_DIM), lam)
        od = (rmsnorm(od, diff_subln[l], eps=1e-5) * (1.0 - lam_init)).reshape(bn, s_len, DIFF_WIDTH)

        q_r = rq.reshape(bn, s_len, RET_HEADS, RET_KEY_DIM).astype(f32)
        k_r = rk.reshape(bn, s_len, RET_HEADS, RET_KEY_DIM).astype(f32)
        q_r = q_r * cos + rotate_every_two(q_r) * sin
        k_r = (k_r * cos + rotate_every_two(k_r) * sin) * RET_KEY_DIM ** -0.5
        v_r = rv.reshape(bn, s_len, RET_HEADS, RET_VAL_DIM).astype(f32)
        o_r = group_norm_heads(retention_chunkwise(q_r, k_r, v_r, log_g)).reshape(bn, s_len, RET_WIDTH)
        o_r = (jax.nn.silu(rg.astype(f32)) * o_r).astype(x.dtype)

        hl = rg_lru_branch(lx, lru_conv_w[l], lru_conv_b[l], lru_wa[l], lru_ba[l], lru_wx[l], lru_bx[l], lru_lambda[l])
        o_l = hl * jax.nn.gelu(ly)

        g = jax.nn.sigmoid(gates.reshape(bn, s_len, N_BRANCH, D_MODEL))
        merged = (g[:, :, 0] * (od @ w_branch[l, 0])
                  + g[:, :, 1] * (o_r @ w_branch[l, 1])
                  + g[:, :, 2] * (o_l @ w_branch[l, 2]))
        x = x + merged @ w_out[l]

        hx = rmsnorm(x, norm_xattn[l])
        hm = rmsnorm(mem, norm_mem[l])
        q_x = (hx @ xa_wq[l]).reshape(bn, s_len, XA_HEADS, XA_HEAD_DIM)
        kv_m = (hm @ xa_wkv[l]).reshape(bn, m_len, 2, XA_HEADS, XA_HEAD_DIM)
        s_x = jnp.einsum('bshd,bmhd->bhsm', q_x, kv_m[:, :, 0]).astype(f32) * XA_HEAD_DIM ** -0.5
        p_x = jax.nn.softmax(s_x, axis=-1)
        o_x = jnp.einsum('bhsm,bmhd->bshd', p_x.astype(x.dtype), kv_m[:, :, 1]).reshape(bn, s_len, XA_WIDTH)
        x = x + o_x @ xa_wo[l]

        hf = rmsnorm(x, norm_mlp[l])
        x = x + jnp.square(jax.nn.relu(hf @ mlp_w1[l])) @ mlp_w2[l]

    return rmsnorm(x, norm_final)
```

```cpp
#include <hip/hip_runtime.h>
#include <hip/hip_cooperative_groups.h>
#include <cstdio>
#include <cstdint>
namespace cg = cooperative_groups;

namespace pg8 {
#define PG8_LAS __attribute__((address_space(3)))
typedef unsigned short bf16_t;
typedef short bf16x8 __attribute__((ext_vector_type(8)));
typedef float f32x4 __attribute__((ext_vector_type(4)));
typedef unsigned u32x4 __attribute__((ext_vector_type(4)));
constexpr int BM = 256, BK = 64, HALF = 128, HTB = HALF * BK * 2  , STAGE_BYTES = 8 * HTB, NXCD = 8, WGM = 8;

__host__ __device__ __forceinline__ int lds_byte(int r, int c) { const int st = (r >> 4) * 2 + (c >> 5), rr = r & 15, cc = c & 31, ob = rr * 64 + cc * 2; return st * 1024 + (ob ^ (((ob >> 9) & 1) << 5)); }
__host__ __device__ __forceinline__ void stage_rc(int b, int& R, int& C) { const int st = b / 1024, sb = b % 1024, swz = sb ^ (((sb >> 9) & 1) << 5); R = (st >> 1) * 16 + swz / 64; C = (st & 1) * 32 + (swz % 64) / 2; }
__host__ __device__ __forceinline__ int perm32(int rho) { const int n = rho >> 4, i = rho & 15; return 8 * (i >> 2) + 4 * n + (i & 3); }

struct Unit { const char* a; const char* b; int pm, pn, aux; };
struct Gemm { int K; };

__device__ __forceinline__ unsigned cvt_pk_bf16(float lo, float hi) { unsigned r; asm volatile("v_cvt_pk_bf16_f32 %0, %1, %2" : "=v"(r) : "v"(lo), "v"(hi)); return r; }
typedef float f32x2 __attribute__((ext_vector_type(2)));
template <class Epi, class Sched, bool ALIGN_EPI = false, bool SP2 = false>
__device__ __forceinline__ void gemm_phase(PG8_LAS unsigned char* lds, const int tid_in, const Gemm g, const Sched& S, const Epi& E) {
    const int tid = tid_in, wid = __builtin_amdgcn_readfirstlane(tid >> 6), lane = tid & 63, wr = wid >> 2, wc = wid & 3, fr = lane & 15, fq = lane >> 4;
    const int K = g.K, nt = K / BK;
    unsigned voffA[2], voffB[2];
#pragma unroll
    for (int i = 0; i < 2; ++i) { int R, C; stage_rc(tid * 16 + i * 8192, R, C); const int Rb = Epi::PERM ? ((R & ~31) + perm32(R & 31)) : R;
        voffA[i] = (unsigned)(R * K + C) * 2u; voffB[i] = (unsigned)(Rb * K + C) * 2u; }
    const size_t kstep = (size_t)(BK * 2);
    const size_t hstep = (size_t)HALF * K * 2;
    const unsigned ldsw = (unsigned)wid * 1024u;
    const int aoff = lds_byte(wr * 64 + fr, fq * 8), boff = lds_byte(wc * 32 + fr, fq * 8);
#define PG8_SA(b, h) (((b) * 2 + (h)) * HTB)
#define PG8_SB(b, h) ((4 + (b) * 2 + (h)) * HTB)
#define PG8_STAGE(bufoff, gbase, voff) do { _Pragma("unroll") for (int _i = 0; _i < 2; ++_i) \
        __builtin_amdgcn_global_load_lds((const unsigned*)((const char*)(gbase) + (voff)[_i]), (PG8_LAS unsigned*)(lds + (bufoff) + ldsw + _i * 8192), 16, 0, 0); } while (0)
#define PG8_LDA(dst, b, h) do { _Pragma("unroll") for (int m = 0; m < 4; ++m) _Pragma("unroll") for (int k = 0; k < 2; ++k) dst[m][k] = *(const PG8_LAS bf16x8*)(lds + PG8_SA(b, h) + aoff + m * 2048 + k * 1024); } while (0)
#define PG8_LDB(dst, b, h) do { _Pragma("unroll") for (int n = 0; n < 2; ++n) _Pragma("unroll") for (int k = 0; k < 2; ++k) dst[n][k] = *(const PG8_LAS bf16x8*)(lds + PG8_SB(b, h) + boff + n * 2048 + k * 1024); } while (0)
#define PG8_MMA(ai, bj, At, Bt) do { __builtin_amdgcn_s_setprio(1); _Pragma("unroll") for (int m = 0; m < 4; ++m) _Pragma("unroll") for (int n = 0; n < 2; ++n) _Pragma("unroll") for (int k = 0; k < 2; ++k) \
        acc[ai][bj][m][n] = __builtin_amdgcn_mfma_f32_16x16x32_bf16(Bt[n][k], At[m][k], acc[ai][bj][m][n], 0, 0, 0); __builtin_amdgcn_s_setprio(0); } while (0)
#define PG8_WAIT_V(n) asm volatile("s_waitcnt vmcnt(" #n ")" ::: "memory")
#define PG8_WAIT_L(n) asm volatile("s_waitcnt lgkmcnt(" #n ")" ::: "memory")
#define PG8_BAR __builtin_amdgcn_s_barrier()
#define PG8_SCHED __builtin_amdgcn_sched_barrier(0)
    Unit cur, nxt; int ui = 0;
    if (!S.next(0, cur)) return;
    f32x4 acc[2][2][4][2];
#pragma unroll
    for (int a = 0; a < 2; ++a)
#pragma unroll
        for (int b = 0; b < 2; ++b)
#pragma unroll
            for (int m = 0; m < 4; ++m)
#pragma unroll
                for (int n = 0; n < 2; ++n) acc[a][b][m][n] = (f32x4){0.f, 0.f, 0.f, 0.f};
    bf16x8 At[4][2], B0[2][2], B1[2][2];
    const char* cA = cur.a; const char* cB = cur.b;
    if constexpr (SP2) {
        PG8_STAGE(PG8_SB(0, 0), cB, voffB); PG8_STAGE(PG8_SB(0, 1), cB + hstep, voffB); PG8_STAGE(PG8_SA(0, 0), cA, voffA); PG8_STAGE(PG8_SA(0, 1), cA + hstep, voffA);
        if (wr == 1) PG8_BAR;
        PG8_WAIT_V(2); PG8_BAR;
        PG8_STAGE(PG8_SB(1, 0), cB + kstep, voffB); PG8_STAGE(PG8_SA(1, 0), cA + kstep, voffA); PG8_STAGE(PG8_SB(1, 1), cB + hstep + kstep, voffB);
        PG8_WAIT_V(6); PG8_BAR;
    } else {
        PG8_STAGE(PG8_SB(0, 0), cB, voffB); PG8_STAGE(PG8_SA(0, 0), cA, voffA); PG8_STAGE(PG8_SB(0, 1), cB + hstep, voffB); PG8_STAGE(PG8_SA(0, 1), cA + hstep, voffA);
        if (wr == 1) PG8_BAR;
        PG8_WAIT_V(4); PG8_BAR;
        PG8_STAGE(PG8_SB(1, 0), cB + kstep, voffB); PG8_STAGE(PG8_SA(1, 0), cA + kstep, voffA); PG8_STAGE(PG8_SB(1, 1), cB + hstep + kstep, voffB);
        PG8_WAIT_V(6); PG8_BAR;
    }
    for (;;) {
        const bool has_next = S.next(ui + 1, nxt);
        const char* nA = has_next ? nxt.a : cA; const char* nB = has_next ? nxt.b : cB;
        for (int t = 0; t < nt; t += 2) {
            const bool last = (t == nt - 2);
            const char* a1 = cA + (size_t)(t + 1) * kstep;
            const char* a2 = last ? nA : cA + (size_t)(t + 2) * kstep; const char* b2 = last ? nB : cB + (size_t)(t + 2) * kstep;
            const char* a3 = a2 + kstep; const char* b3 = b2 + kstep;
            if constexpr (SP2) {
            PG8_LDB(B0, 0, 0); PG8_LDB(B1, 0, 1); PG8_SCHED; PG8_LDA(At, 0, 0); PG8_STAGE(PG8_SA(1, 1), a1 + hstep, voffA);
            PG8_WAIT_V(8); PG8_WAIT_L(0); PG8_BAR; PG8_MMA(0, 0, At, B0); PG8_MMA(0, 1, At, B1); PG8_BAR; PG8_SCHED;
            PG8_LDA(At, 0, 1); PG8_STAGE(PG8_SB(0, 0), b2, voffB); PG8_STAGE(PG8_SB(0, 1), b2 + hstep, voffB); PG8_STAGE(PG8_SA(0, 0), a2, voffA);
            PG8_WAIT_V(8); PG8_WAIT_L(0); PG8_BAR; PG8_MMA(1, 0, At, B0); PG8_MMA(1, 1, At, B1); PG8_BAR; PG8_SCHED;
            PG8_LDB(B0, 1, 0); PG8_LDB(B1, 1, 1); PG8_SCHED; PG8_LDA(At, 1, 0); PG8_STAGE(PG8_SA(0, 1), a2 + hstep, voffA);
            PG8_WAIT_V(8); PG8_WAIT_L(0); PG8_BAR; PG8_MMA(0, 0, At, B0); PG8_MMA(0, 1, At, B1); PG8_BAR; PG8_SCHED;
            PG8_LDA(At, 1, 1); PG8_STAGE(PG8_SB(1, 0), b3, voffB); PG8_STAGE(PG8_SB(1, 1), b3 + hstep, voffB); PG8_STAGE(PG8_SA(1, 0), a3, voffA);
            PG8_WAIT_V(8); PG8_WAIT_L(0); PG8_BAR; PG8_MMA(1, 0, At, B0); PG8_MMA(1, 1, At, B1); PG8_BAR; PG8_SCHED;
            } else {
            PG8_LDB(B0, 0, 0); PG8_SCHED; PG8_LDA(At, 0, 0); PG8_STAGE(PG8_SA(1, 1), a1 + hstep, voffA);
            PG8_WAIT_L(8); PG8_BAR; PG8_WAIT_L(0); PG8_MMA(0, 0, At, B0); PG8_BAR; PG8_SCHED;
            PG8_LDB(B1, 0, 1); PG8_STAGE(PG8_SB(0, 0), b2, voffB);
            PG8_BAR; PG8_WAIT_L(0); PG8_MMA(0, 1, At, B1); PG8_BAR;
            PG8_LDA(At, 0, 1); PG8_STAGE(PG8_SA(0, 0), a2, voffA);
            PG8_BAR; PG8_WAIT_L(0); PG8_MMA(1, 0, At, B0); PG8_BAR; PG8_SCHED;
            PG8_STAGE(PG8_SB(0, 1), b2 + hstep, voffB);
            PG8_WAIT_V(6); PG8_BAR; PG8_MMA(1, 1, At, B1); PG8_BAR;
            PG8_LDB(B0, 1, 0); PG8_SCHED; PG8_LDA(At, 1, 0); PG8_STAGE(PG8_SA(0, 1), a2 + hstep, voffA);
            PG8_WAIT_L(8); PG8_BAR; PG8_WAIT_L(0); PG8_MMA(0, 0, At, B0); PG8_BAR; PG8_SCHED;
            PG8_LDB(B1, 1, 1); PG8_STAGE(PG8_SB(1, 0), b3, voffB);
            PG8_BAR; PG8_WAIT_L(0); PG8_MMA(0, 1, At, B1); PG8_BAR;
            PG8_LDA(At, 1, 1); PG8_STAGE(PG8_SA(1, 0), a3, voffA);
            PG8_BAR; PG8_WAIT_L(0); PG8_MMA(1, 0, At, B0); PG8_BAR; PG8_SCHED;
            PG8_STAGE(PG8_SB(1, 1), b3 + hstep, voffB);
            PG8_WAIT_V(6); PG8_BAR; PG8_MMA(1, 1, At, B1); PG8_BAR;
            }
        }
        if constexpr (ALIGN_EPI) { if (wr == 0) PG8_BAR; }
        E(acc, cur, wr, wc, fr, fq);
        if (!has_next) break;
        if (!E.keep(cur))
#pragma unroll
        for (int a = 0; a < 2; ++a)
#pragma unroll
            for (int b = 0; b < 2; ++b)
#pragma unroll
                for (int m = 0; m < 4; ++m)
#pragma unroll
                    for (int n = 0; n < 2; ++n) acc[a][b][m][n] = (f32x4){0.f, 0.f, 0.f, 0.f};
        cur = nxt; cA = nA; cB = nB; ++ui;
        if constexpr (ALIGN_EPI) { if (wr == 1) PG8_BAR; }
    }
    PG8_WAIT_V(0);
    if constexpr (!ALIGN_EPI) { if (wr == 0) PG8_BAR; }
    PG8_BAR;
#undef PG8_SA
#undef PG8_SB
#undef PG8_STAGE
#undef PG8_LDA
#undef PG8_LDB
#undef PG8_MMA
#undef PG8_WAIT_V
#undef PG8_WAIT_L
#undef PG8_BAR
#undef PG8_SCHED
}
}
#include <hip/hip_bf16.h>
#include <cmath>
namespace attn_body {
using bf16=__hip_bfloat16;
using bf16x8=__attribute__((ext_vector_type(8)))short;
using s16x4=__attribute__((ext_vector_type(4)))short;
using f32x16=__attribute__((ext_vector_type(16)))float;
using u32x4=__attribute__((ext_vector_type(4)))unsigned;
constexpr int BATCH=8,NHEAD=8,SEQ=2048,D=64,DM=64,OP=2048;
constexpr int NW=8,QBLK=32,QB=QBLK*NW,KVBLK=64,NQB=SEQ/QB;
constexpr int ATTN_PITCH=DM, ATTN_UNIT_ROWS=QB;
__device__ __forceinline__ int crow(int r,int hi){return (r&3)+8*(r>>2)+4*hi;}
#define SBAR() __builtin_amdgcn_sched_barrier(0)
__device__ __forceinline__ void cmask(f32x16&p0,f32x16&p1,int jb,int qrel,int hi){
  const float NEG=-INFINITY; int kb=64*jb+4*hi;
  #pragma unroll
  for(int r=0;r<16;++r){int kv=kb+(r&3)+8*(r>>2); if(kv>qrel)p0[r]=NEG; if(kv+32>qrel)p1[r]=NEG;}
}

constexpr int NSLOT=3, SLOTB=8192;
constexpr int LDS_K=0, LDS_V=NSLOT*SLOTB, LDS_WS=2*NSLOT*SLOTB, LDS_OST=LDS_WS+NW*64*4, LDS_BYTES=LDS_OST+NW*4096;
constexpr float C2=0.125f*1.4426950408889634f;
__device__ __forceinline__ void glds16(const void*gsrc,unsigned lds_dst){unsigned keep;
  asm volatile("s_mov_b32 %0, m0\n\ts_mov_b32 m0, %2\n\ts_nop 0\n\tglobal_load_lds_dwordx4 %1, off\n\ts_mov_b32 m0, %0":"=&s"(keep):"v"(gsrc),"s"(lds_dst):"memory");}
__device__ __forceinline__ float max3f(float a,float b,float c){float r;asm("v_max3_f32 %0, %1, %2, %3":"=v"(r):"v"(a),"v"(b),"v"(c));return r;}
__device__ __forceinline__ float max2f(float a,float b){float r;asm("v_max_f32_e32 %0, %1, %2":"=v"(r):"v"(a),"v"(b));return r;}
__device__ __forceinline__ float fadd_s(float a,float b){float r;asm("v_add_f32_e32 %0, %1, %2":"=v"(r):"v"(a),"v"(b));return r;}
__device__ __forceinline__ float fsub_s(float a,float b){float r;asm("v_sub_f32_e32 %0, %1, %2":"=v"(r):"v"(a),"v"(b));return r;}
typedef float f32x2_t __attribute__((ext_vector_type(2))); typedef __bf16 bf16x2_t __attribute__((ext_vector_type(2)));
__device__ __forceinline__ unsigned cvtpk_s(float lo,float hi){f32x2_t v={lo,hi};bf16x2_t b=__builtin_convertvector(v,bf16x2_t);return __builtin_bit_cast(unsigned,b);}
#define WAIT_BAR(N) asm volatile("s_waitcnt vmcnt(" #N ") lgkmcnt(0)\n\ts_barrier":::"memory")

__device__ __forceinline__ void qkt(f32x16&p0,f32x16&p1,const char*Kslot,const bf16x8*qr,const f32x16&negm,int r32,int hi){
  const char*kb=Kslot+hi*1024+r32*16;
  #pragma unroll
  for(int d0=0;d0<4;++d0){
    const bf16x8 b0=*reinterpret_cast<const bf16x8*>(kb+d0*2048);
    const bf16x8 b1=*reinterpret_cast<const bf16x8*>(kb+d0*2048+512);
    if(d0==0){p0=__builtin_amdgcn_mfma_f32_32x32x16_bf16(b0,qr[0],negm,0,0,0);p1=__builtin_amdgcn_mfma_f32_32x32x16_bf16(b1,qr[0],negm,0,0,0);}
    else{p0=__builtin_amdgcn_mfma_f32_32x32x16_bf16(b0,qr[d0],p0,0,0,0);p1=__builtin_amdgcn_mfma_f32_32x32x16_bf16(b1,qr[d0],p1,0,0,0);}}
}
typedef __attribute__((address_space(3))) const char* lds_cptr;
typedef short v4i16_t __attribute__((ext_vector_type(4)));
__device__ __forceinline__ void kload8(bf16x8*kf,lds_cptr kp){
  kf[0]=*(const __attribute__((address_space(3))) bf16x8*)(kp);      kf[1]=*(const __attribute__((address_space(3))) bf16x8*)(kp+512);
  kf[2]=*(const __attribute__((address_space(3))) bf16x8*)(kp+2048); kf[3]=*(const __attribute__((address_space(3))) bf16x8*)(kp+2560);
  kf[4]=*(const __attribute__((address_space(3))) bf16x8*)(kp+4096); kf[5]=*(const __attribute__((address_space(3))) bf16x8*)(kp+4608);
  kf[6]=*(const __attribute__((address_space(3))) bf16x8*)(kp+6144); kf[7]=*(const __attribute__((address_space(3))) bf16x8*)(kp+6656);
}
__device__ __forceinline__ void kload2(bf16x8*kf,lds_cptr kp,int j){ kf[2*j]=*(const __attribute__((address_space(3))) bf16x8*)(kp+j*2048); kf[2*j+1]=*(const __attribute__((address_space(3))) bf16x8*)(kp+j*2048+512); }
__device__ __forceinline__ s16x4 vtr(lds_cptr p){ return __builtin_bit_cast(s16x4,__builtin_amdgcn_ds_read_tr16_b64_v4i16((__attribute__((address_space(3))) v4i16_t*)p)); }
__device__ __forceinline__ float rowmax(const f32x16&p0,const f32x16&p1){
  float a=max3f(p0[0],p0[1],p1[0]),b=max3f(p0[2],p0[3],p1[1]);a=max3f(a,p1[2],p1[3]);
  #pragma unroll
  for(int r=4;r<16;r+=4){a=max3f(a,p0[r],p0[r+1]);b=max3f(b,p0[r+2],p0[r+3]);a=max3f(a,p1[r],p1[r+1]);b=max3f(b,p1[r+2],p1[r+3]);}
  const float m=max2f(a,b);
  auto rr=__builtin_amdgcn_permlane32_swap(__float_as_uint(m),__float_as_uint(m),false,false);
  return max2f(__uint_as_float(rr[0]),__uint_as_float(rr[1]));
}
__device__ __forceinline__ void pv(f32x16*o,int vb,bf16x8 pa0,bf16x8 pa1,bf16x8 pa2,bf16x8 pa3){
  #pragma unroll
  for(int d0=0;d0<2;++d0){s16x4 lo[4],hi[4];
    #pragma unroll
    for(int ks=0;ks<4;++ks){
      asm volatile("ds_read_b64_tr_b16 %0,%1 offset:%c2":"=&v"(lo[ks]):"v"(vb),"i"(d0*4096+ks*1024):"memory");
      asm volatile("ds_read_b64_tr_b16 %0,%1 offset:%c2":"=&v"(hi[ks]):"v"(vb),"i"(d0*4096+ks*1024+512):"memory");}
    asm volatile("s_waitcnt lgkmcnt(0)":::"memory");SBAR();
    #define PK(k) (bf16x8){lo[k][0],lo[k][1],lo[k][2],lo[k][3],hi[k][0],hi[k][1],hi[k][2],hi[k][3]}
    o[d0]=__builtin_amdgcn_mfma_f32_32x32x16_bf16(pa0,PK(0),o[d0],0,0,0);
    o[d0]=__builtin_amdgcn_mfma_f32_32x32x16_bf16(pa1,PK(1),o[d0],0,0,0);
    o[d0]=__builtin_amdgcn_mfma_f32_32x32x16_bf16(pa2,PK(2),o[d0],0,0,0);
    o[d0]=__builtin_amdgcn_mfma_f32_32x32x16_bf16(pa3,PK(3),o[d0],0,0,0);
    #undef PK
  }
}

#ifndef ATTN_STORE16
#define ATTN_STORE16(p,v) (*(u32x4*)(p)=(v))
#endif
template<int THRL> __device__ __forceinline__ void attn_unit(int b,int h,int qb,const bf16*Q,const bf16*__restrict__ K,const bf16*__restrict__ V,bf16*O,char*shm,const int tid_in){
  const int tid=tid_in,lane=tid&63,r32=lane&31,hi=lane>>5; const int wid=__builtin_amdgcn_readfirstlane(tid>>6);
  const long rowbase=(long)b*SEQ; const int q0=qb*QB;
  const bf16*Qw=Q+(rowbase+q0+wid*QBLK)*DM+h*D;
  const bf16*Kh=K+rowbase*DM+h*D,*Vh=V+rowbase*DM+h*D;
  const unsigned lds0=(unsigned)(uintptr_t)shm;
  float*wsf=(float*)(shm+LDS_WS)+wid*64;
  const bf16*ksrc=Kh+(long)lane*DM+wid*8;
  const bf16*vsrc=Vh+(long)(16*(wid&3)+(lane>>2))*DM+(wid>>2)*32+(lane&3)*8;
  const unsigned kdst=lds0+LDS_K+wid*1024, vdst=lds0+LDS_V+wid*1024;
  #define DMA_K(t,slot) glds16(ksrc+(long)(t)*KVBLK*DM,(unsigned)__builtin_amdgcn_readfirstlane(kdst+(slot)))
  #define DMA_V(t,slot) glds16(vsrc+(long)(t)*KVBLK*DM,(unsigned)__builtin_amdgcn_readfirstlane(vdst+(slot)))
  const int vb0=(int)(lds0+LDS_V)+((lane>>4)&1)*32+(lane&3)*8+(4*hi+((lane&15)>>2))*64;
  const char*Kbase=shm+LDS_K; bf16x8 kf[8];
  const lds_cptr shm3=(lds_cptr)shm; const lds_cptr kp0=shm3+LDS_K+hi*1024+r32*16; const lds_cptr vp0=shm3+LDS_V+((lane>>4)&1)*32+(lane&3)*8+(4*hi+((lane&15)>>2))*64;
  const int NT=(q0+QB)/KVBLK;
  DMA_K(0,0);DMA_V(0,0);DMA_K(1,SLOTB);
  bf16x8 qr[4];
  #pragma unroll
  for(int d0=0;d0<4;++d0)qr[d0]=*reinterpret_cast<const bf16x8*>(&Qw[(long)r32*DM+d0*16+hi*8]);
  float mhat=0.f,l_reg=0.f;f32x16 o[2];o[0]=f32x16{};o[1]=f32x16{};f32x16 negm=f32x16{};asm volatile("":"+v"(negm));
  const int qrel=wid*QBLK+r32;
  #define CMASK(P0,P1,t) do{int jb_=(t)-(NT-4); if(jb_>=0)cmask(P0,P1,jb_,qrel,hi);}while(0)
  bool resc=false;
  #define START(P0,P1) do{ const float rm=rowmax(P0,P1); resc=false; \
    { const float dl=rm; mhat=fadd_s(mhat,dl); \
      _Pragma("unroll") for(int r=0;r<16;++r){P0[r]=fsub_s(P0[r],dl);P1[r]=fsub_s(P1[r],dl);} \
      _Pragma("unroll") for(int r=0;r<16;++r)negm[r]=-mhat; asm volatile("":"+v"(negm)); } \
    _Pragma("unroll") for(int r=0;r<16;++r)P0[r]=__builtin_amdgcn_exp2f(P0[r]); }while(0)
  #define RESC() do{ if(resc){ asm volatile("s_waitcnt lgkmcnt(0)":::"memory"); \
      _Pragma("unroll") for(int d_=0;d_<2;++d_) _Pragma("unroll") for(int r=0;r<16;++r)o[d_][r]*=wsf[crow(r,hi)]; } }while(0)
  f32x16 pA0,pA1,pB0,pB1;
  int sl_prev=0,sl_cur=0,sl_next=SLOTB;
  #define ROT() do{sl_prev=sl_cur;sl_cur=sl_next;sl_next=(sl_next==(NSLOT-1)*SLOTB)?0:sl_next+SLOTB;}while(0)
  DMA_K(2,2*SLOTB);
  WAIT_BAR(3);
  qkt(pA0,pA1,Kbase,qr,negm,r32,hi);asm volatile("s_nop 15\n\ts_nop 7":"+v"(pA0),"+v"(pA1));CMASK(pA0,pA1,0);
  START(pA0,pA1);
  _Pragma("unroll") for(int r=0;r<16;++r)pA1[r]=__builtin_amdgcn_exp2f(pA1[r]);
  WAIT_BAR(0);
  DMA_K(3,0);DMA_V(1,SLOTB);
  ROT();
  kload8(kf,kp0+sl_cur);
  WAIT_BAR(2);
  s16x4 vlo[8],vhi[8]; u32x4 pw0,pw1,pw2,pw3;
  #define PKW(P,B) cvtpk_s(P[B],P[B+1])
  #define PAF(k) __builtin_bit_cast(bf16x8,pw##k)
  #define VFR(i) (bf16x8){vlo[i][0],vlo[i][1],vlo[i][2],vlo[i][3],vhi[i][0],vhi[i][1],vhi[i][2],vhi[i][3]}
  #define PIN(x) asm volatile("":"+v"(x))
  #define MX3(a,b,c) __builtin_fmaxf(__builtin_fmaxf((a),(b)),(c))
  #define GAPA(MF,A0,A1,A2,A3,W0,W1,PW) do{ MF; sacc+=A0; sacc+=A1; sacc+=A2; sacc+=A3; PIN(sacc); W0; W1; PIN(PW); SBAR(); }while(0)
  #define EX(v) __builtin_amdgcn_exp2f(v)
  #define GAPB(MF,X,B) do{ MF; X[B]=EX(X[B]); X[B+1]=EX(X[B+1]); X[B+2]=EX(X[B+2]); X[B+3]=EX(X[B+3]); PIN(X); SBAR(); }while(0)
  #define VRD(i) do{ vlo[i]=vtr(vp_+(((i)>>2)*4096+((i)&3)*1024)); vhi[i]=vtr(vp_+(((i)>>2)*4096+((i)&3)*1024+512)); }while(0)
  #define KRD(G,j) do{ if(G){ kload2(kf,kp0+sl_next,j); SBAR(); } }while(0)
  #define STEP(C0,C1,P0,P1,t,GK,GV,GL) do{ SBAR(); \
    const lds_cptr vp_=vp0+sl_prev; \
    VRD(0); SBAR(); float sacc=(P0[0]+P0[1]); \
    GAPA(C0=__builtin_amdgcn_mfma_f32_32x32x16_bf16(kf[0],qr[0],negm,0,0,0), P0[2],P0[3],P0[4],P0[5],     pw0[0]=PKW(P0,0), pw0[1]=PKW(P0,2), pw0); \
    VRD(4); SBAR(); GAPA(C1=__builtin_amdgcn_mfma_f32_32x32x16_bf16(kf[1],qr[0],negm,0,0,0), P0[6],P0[7],P0[8],P0[9],     pw0[2]=PKW(P0,4), pw0[3]=PKW(P0,6), pw0); \
    VRD(1); SBAR(); GAPA(C0=__builtin_amdgcn_mfma_f32_32x32x16_bf16(kf[2],qr[1],C0,0,0,0),   P0[10],P0[11],P0[12],P0[13], pw1[0]=PKW(P0,8), pw1[1]=PKW(P0,10), pw1); \
    VRD(5); SBAR(); GAPA(C1=__builtin_amdgcn_mfma_f32_32x32x16_bf16(kf[3],qr[1],C1,0,0,0),   P0[14],P0[15],P1[0],P1[1],   pw1[2]=PKW(P0,12),pw1[3]=PKW(P0,14), pw1); \
    VRD(2); SBAR(); GAPA(C0=__builtin_amdgcn_mfma_f32_32x32x16_bf16(kf[4],qr[2],C0,0,0,0),   P1[2],P1[3],P1[4],P1[5],     pw2[0]=PKW(P1,0), pw2[1]=PKW(P1,2), pw2); \
    VRD(6); SBAR(); GAPA(C1=__builtin_amdgcn_mfma_f32_32x32x16_bf16(kf[5],qr[2],C1,0,0,0),   P1[6],P1[7],P1[8],P1[9],     pw2[2]=PKW(P1,4), pw2[3]=PKW(P1,6), pw2); \
    VRD(3); SBAR(); GAPA(C0=__builtin_amdgcn_mfma_f32_32x32x16_bf16(kf[6],qr[3],C0,0,0,0),   P1[10],P1[11],P1[12],P1[13], pw3[0]=PKW(P1,8), pw3[1]=PKW(P1,10), pw3); \
    VRD(7); SBAR(); GAPA(C1=__builtin_amdgcn_mfma_f32_32x32x16_bf16(kf[7],qr[3],C1,0,0,0),   P1[14],P1[15],0.f,0.f,       pw3[2]=PKW(P1,12),pw3[3]=PKW(P1,14), pw3); \
    l_reg+=sacc; \
    if(GK){DMA_K((t)+3,sl_cur);} if(GV){DMA_V((t)+1,sl_next);} \
    CMASK(C0,C1,t); \
    { float a=MX3(C0[0],C0[1],C1[0]),b=MX3(C0[2],C0[3],C1[1]); a=MX3(a,C1[2],C1[3]); \
      _Pragma("unroll") for(int r=4;r<16;r+=4){a=MX3(a,C0[r],C0[r+1]);b=MX3(b,C0[r+2],C0[r+3]);a=MX3(a,C1[r],C1[r+1]);b=MX3(b,C1[r+2],C1[r+3]);} \
      float rm=__builtin_fmaxf(a,b); { auto rr=__builtin_amdgcn_permlane32_swap(__float_as_uint(rm),__float_as_uint(rm),false,false); rm=__builtin_fmaxf(__uint_as_float(rr[0]),__uint_as_float(rr[1])); } \
      resc=false; \
      if(__builtin_expect(__any(rm>(float)THRL),0)){ const float dl=__builtin_fmaxf(rm,0.f); mhat+=dl; \
        _Pragma("unroll") for(int r=0;r<16;++r){C0[r]-=dl;C1[r]-=dl;} \
        _Pragma("unroll") for(int r=0;r<16;++r)negm[r]=-mhat; asm volatile("":"+v"(negm)); \
        const float f=__builtin_amdgcn_exp2f(-dl); l_reg*=f; if(hi==0)wsf[r32]=f; resc=true; } } \
    SBAR(); \
    GAPB(o[0]=__builtin_amdgcn_mfma_f32_32x32x16_bf16(PAF(0),VFR(0),o[0],0,0,0), C0,0); \
    GAPB(o[1]=__builtin_amdgcn_mfma_f32_32x32x16_bf16(PAF(0),VFR(4),o[1],0,0,0), C0,4); \
    KRD(GL,0); GAPB(o[0]=__builtin_amdgcn_mfma_f32_32x32x16_bf16(PAF(1),VFR(1),o[0],0,0,0), C0,8); \
    KRD(GL,1); GAPB(o[1]=__builtin_amdgcn_mfma_f32_32x32x16_bf16(PAF(1),VFR(5),o[1],0,0,0), C0,12); \
    KRD(GL,2); GAPB(o[0]=__builtin_amdgcn_mfma_f32_32x32x16_bf16(PAF(2),VFR(2),o[0],0,0,0), C1,0); \
    KRD(GL,3); GAPB(o[1]=__builtin_amdgcn_mfma_f32_32x32x16_bf16(PAF(2),VFR(6),o[1],0,0,0), C1,4); \
    GAPB(o[0]=__builtin_amdgcn_mfma_f32_32x32x16_bf16(PAF(3),VFR(3),o[0],0,0,0), C1,8); \
    GAPB(o[1]=__builtin_amdgcn_mfma_f32_32x32x16_bf16(PAF(3),VFR(7),o[1],0,0,0), C1,12); \
    }while(0)
  int t=1;
  #undef CMASK
  #define CMASK(P0,P1,t) do{}while(0)
  for(;t+5<NT;t+=2){
    STEP(pB0,pB1,pA0,pA1,t,true,true,true);     WAIT_BAR(2); RESC(); ROT();
    STEP(pA0,pA1,pB0,pB1,t+1,true,true,true);   WAIT_BAR(2); RESC(); ROT();
  }
  #undef CMASK
  #define CMASK(P0,P1,t) do{int jb_=(t)-(NT-4); if(jb_>=0)cmask(P0,P1,jb_,qrel,hi);}while(0)
  #define ENDW(tt) do{ if((tt)+3<NT){WAIT_BAR(2);} else if((tt)+2<NT){WAIT_BAR(1);} else {WAIT_BAR(0);} }while(0)
  for(;t+1<NT;t+=2){
    STEP(pB0,pB1,pA0,pA1,t,(t+3<NT),(t+1<NT),(t+1<NT));       ENDW(t);   RESC(); ROT();
    STEP(pA0,pA1,pB0,pB1,t+1,(t+4<NT),(t+2<NT),(t+2<NT));     ENDW(t+1); RESC(); ROT();
  }
  STEP(pB0,pB1,pA0,pA1,NT-1,false,false,false); RESC();
  { float sacc=pB0[0]+pB0[1]; _Pragma("unroll") for(int r=2;r<16;++r)sacc+=pB0[r]; _Pragma("unroll") for(int r=0;r<16;++r)sacc+=pB1[r]; l_reg+=sacc;
    pw0=(u32x4){PKW(pB0,0),PKW(pB0,2),PKW(pB0,4),PKW(pB0,6)};pw1=(u32x4){PKW(pB0,8),PKW(pB0,10),PKW(pB0,12),PKW(pB0,14)};pw2=(u32x4){PKW(pB1,0),PKW(pB1,2),PKW(pB1,4),PKW(pB1,6)};pw3=(u32x4){PKW(pB1,8),PKW(pB1,10),PKW(pB1,12),PKW(pB1,14)};
    SBAR(); pv(o,vb0+sl_cur,PAF(0),PAF(1),PAF(2),PAF(3)); }
  #undef PKW
  #undef PAF
  #undef VFR
  #undef PIN
  #undef MX3
  #undef GAPA
  #undef GAPB
  #undef EX
  #undef VRD
  #undef KRD
  #undef STEP
  #undef ENDW
  {auto rr=__builtin_amdgcn_permlane32_swap(__float_as_uint(l_reg),__float_as_uint(l_reg),false,false);l_reg=__uint_as_float(rr[0])+__uint_as_float(rr[1]);}
  if(hi==0)wsf[32+r32]=l_reg;asm volatile("s_waitcnt lgkmcnt(0)":::"memory");
  float rli[16];
  #pragma unroll
  for(int r=0;r<16;++r)rli[r]=__builtin_amdgcn_rcpf(wsf[32+crow(r,hi)]);
  bf16*Ow=O+(rowbase+q0+wid*QBLK)*OP+h*D;
  { bf16*stg=(bf16*)(shm+LDS_OST)+wid*2048;
    #pragma unroll
    for(int r=0;r<16;++r){const int orow=crow(r,hi);
      #pragma unroll
      for(int d0=0;d0<2;++d0)stg[orow*64+d0*32+r32]=__float2bfloat16(o[d0][r]*rli[r]);}
    asm volatile("s_waitcnt lgkmcnt(0)":::"memory");
    #pragma unroll
    for(int i=0;i<4;++i){const int row=i*8+(lane>>3),ch=lane&7; const u32x4 v=*(const u32x4*)(stg+row*64+ch*8); ATTN_STORE16(Ow+(long)row*OP+ch*8,v);} }
  asm volatile("s_waitcnt lgkmcnt(0)\n\ts_barrier":::"memory");
  #undef DMA_K
  #undef DMA_V
  #undef CMASK
  #undef START
  #undef RESC
  #undef ROT
}
constexpr int ATTN_LDS_BYTES=LDS_BYTES;
#undef SBAR
#undef WAIT_BAR
}

#define LAS __attribute__((address_space(3)))
typedef unsigned short bf16_t;
typedef short bf16x8 __attribute__((ext_vector_type(8)));
typedef short s16x4 __attribute__((ext_vector_type(4)));
typedef short v4i16_t __attribute__((ext_vector_type(4)));
typedef float f32x4 __attribute__((ext_vector_type(4)));
typedef float f32x16 __attribute__((ext_vector_type(16)));
typedef unsigned u32x4 __attribute__((ext_vector_type(4)));
typedef unsigned u32x2 __attribute__((ext_vector_type(2)));
typedef float f32x2 __attribute__((ext_vector_type(2)));
using pg8::Unit;

constexpr int NB = 8, S = 2048, M = NB * S, D = 1024, DEPTH = 4, INC = 8320, MEMLEN = 256, MM = NB * MEMLEN, FF = 4096;
constexpr int C_RQ = 0, C_RK = 512, C_RV = 1024, C_RG = 2048, C_LX = 3072, C_LY = 4096, C_GT = 5120;
constexpr size_t MiB = 1u << 20;
constexpr size_t WS_TAB = 1 * MiB, WS_RSM = 2 * MiB, WS_SLOT = 3 * MiB, WS_CARRY = 4 * MiB, WS_LRUW = 5 * MiB,
    WS_WIN = 6 * MiB, WS_WBR = 28 * MiB, WS_WOUT = 34 * MiB, WS_WQ = 36 * MiB, WS_WKV = 37 * MiB, WS_WO = 39 * MiB, WS_W1 = 40 * MiB, WS_W2 = 48 * MiB,
    WS_XB = 56 * MiB, WS_MEMB = 88 * MiB, WS_BR = 92 * MiB, WS_OD4 = 188 * MiB, WS_MERGED = 188 * MiB, WS_RETST = 252 * MiB, WS_U = 284 * MiB,
    WS_H = 284 * MiB, WS_QKVC = 544 * MiB, WS_QX = 640 * MiB, WS_KX = 656 * MiB, WS_VXT = 658 * MiB, WS_OX = 660 * MiB, WS_END = 676 * MiB;
constexpr size_t UBS = (size_t)2048 * INC;
constexpr size_t MBS = (size_t)2048 * 2048;
constexpr int LDS_BYTES = 147456, MISC_OFF = 147328;
constexpr float LOG2E = 1.4426950408889634f;
constexpr float C2 = 0.125f * LOG2E;
constexpr float CQ = 0.08838834764831845f * LOG2E;
constexpr float RSQ128 = 0.08838834764831845f;

struct Params { const float* in[27]; float* out; unsigned char* ws; };
typedef __attribute__((address_space(4))) const unsigned char* kaptr_t;
#define KA_GET(ka) kaptr_t ka = (kaptr_t)__builtin_amdgcn_kernarg_segment_ptr(); asm volatile("" : "+s"(ka));
#define GAS1 __attribute__((address_space(1)))
#define PIN(k) ((const float*)(*(const GAS1 float* const __attribute__((address_space(4)))*)(ka + 8 * (k))))
#define POUT ((float*)(*(GAS1 float* const __attribute__((address_space(4)))*)(ka + 216)))
#define PWS (*(GAS1 unsigned char* const __attribute__((address_space(4)))*)(ka + 224))
#define WSP(T, off) ((T*)(GAS1 T*)(ws + (off)))


__device__ __forceinline__ int tid_of(int wave_s) { int l; asm volatile("v_mbcnt_lo_u32_b32 %0, -1, 0\n\tv_mbcnt_hi_u32_b32 %0, -1, %0" : "=v"(l)); return wave_s * 64 + l; }
__device__ __forceinline__ unsigned pk2(float lo, float hi) { return pg8::cvt_pk_bf16(lo, hi); }
__device__ __forceinline__ bf16_t f2bf(float f) { return (bf16_t)(pk2(f, 0.f) & 0xffffu); }
__device__ __forceinline__ float bf2f(bf16_t u) { return __uint_as_float((unsigned)u << 16); }
__device__ __forceinline__ float bflo(unsigned w) { return __uint_as_float(w << 16); }
__device__ __forceinline__ float bfhi(unsigned w) { return __uint_as_float(w & 0xffff0000u); }
__device__ __forceinline__ float wave_sum(float v) {
#pragma unroll
    for (int o = 1; o < 64; o <<= 1) v += __shfl_xor(v, o);
    return v;
}
__device__ __forceinline__ float sigmoidf_(float x) { return __builtin_amdgcn_rcpf(1.f + __expf(-x)); }
__device__ __forceinline__ s16x4 ldtr(const LAS unsigned char* p) { return __builtin_bit_cast(s16x4, __builtin_amdgcn_ds_read_tr16_b64_v4i16((LAS v4i16_t*)p)); }
__device__ __forceinline__ bf16x8 cat8(s16x4 a, s16x4 b) { return (bf16x8){a[0], a[1], a[2], a[3], b[0], b[1], b[2], b[3]}; }
#define MFMA32(a, b, c) __builtin_amdgcn_mfma_f32_32x32x16_bf16((a), (b), (c), 0, 0, 0)
__device__ __forceinline__ int crow(int r, int hi) { return (r & 3) + 8 * (r >> 2) + 4 * hi; }

template <int R, int C> __device__ __forceinline__ void load_tile(LAS unsigned char* dst, int lp, const bf16_t* src, size_t gp, int tid) {
    constexpr int CPR = C / 8, TOT = R * CPR, NP = TOT / 512;
    u32x4 v[NP];
#pragma unroll
    for (int i = 0; i < NP; ++i) { const int idx = tid + i * 512, r = idx / CPR, ch = idx % CPR; v[i] = *(const u32x4*)(src + (size_t)r * gp + ch * 8); }
    asm volatile("" ::: "memory");
#pragma unroll
    for (int i = 0; i < NP; ++i) { const int idx = tid + i * 512, r = idx / CPR, ch = idx % CPR; *(LAS u32x4*)(dst + r * lp + ch * 16) = v[i]; }
}

__device__ __forceinline__ void tile_map(int L, int nM, int nN, int& pm, int& pn) {
    const int nwg = nM * nN; int wgid = L; { const int q = nwg / 8, r = nwg % 8, xcd = wgid % 8, off = wgid / 8; wgid = (xcd < r ? xcd * (q + 1) : r * (q + 1) + (xcd - r) * q) + off; }
    constexpr int GH = 4;
    const int nig = GH * nN, gid = wgid / nig, fm = gid * GH, gsz = (nM - fm) < GH ? (nM - fm) : GH;
    pm = fm + ((wgid % nig) % gsz); pn = (wgid % nig) / gsz;
}
struct SchedStd { const char* A; const char* B; int nM, nN, K, G, c; size_t a_bs; int rev = 0;
    __device__ __forceinline__ bool next(int i, Unit& u) const { const int L = i * G + c; if (L >= nM * nN) return false; int pm, pn; tile_map(L, nM, nN, pm, pn); if (rev) pn = nN - 1 - pn;
        u.pm = pm; u.pn = pn; u.aux = 0; u.a = A + (size_t)(pm >> 3) * a_bs + (size_t)(pm & 7) * 512 * K; u.b = B + (size_t)pn * 512 * K; return true; } };
struct SchedBranch { const char* BR; const char* W; int G, c;
    __device__ __forceinline__ bool next(int i, Unit& u) const { const int t = i / 3, j = i - 3 * t, L = t * G + c; if (L >= 256) return false; int pm, pn; tile_map(L, 64, 4, pm, pn);
        u.pm = pm; u.pn = pn; u.aux = j; u.a = BR + ((size_t)j * M + (size_t)pm * 256) * 2048; u.b = W + ((size_t)j * 1024 + (size_t)pn * 256) * 2048; return true; } };
struct SchedXA { const char* XB; const char* MEMB; const char* WQ; const char* WKV; int G, c;
    __device__ __forceinline__ bool next(int i, Unit& u) const { const int L = i * G + c; if (L >= 160) return false;
        if (L < 128) { int pm, pn; tile_map(L, 64, 2, pm, pn); u.pm = pm; u.pn = pn; u.aux = 0; u.a = XB + (size_t)pm * 524288; u.b = WQ + (size_t)pn * 524288; }
        else if (L < 144) { const int t = L - 128; u.pm = t & 7; u.pn = t >> 3; u.aux = 1; u.a = MEMB + (size_t)u.pm * 524288; u.b = WKV + (size_t)u.pn * 524288; }
        else { const int t = L - 144; u.pm = t >> 3; u.pn = t & 7; u.aux = 2; u.a = WKV + (size_t)(2 + u.pm) * 524288; u.b = MEMB + (size_t)u.pn * 524288; }
        return true; } };

__device__ __forceinline__ float slot_rstd(const float* slots, int row) {
    const f32x4* s = (const f32x4*)(slots + (size_t)row * 16); const f32x4 a = s[0], b = s[1], c = s[2], d = s[3];
    const float t = ((a.x + a.y) + (a.z + a.w)) + ((b.x + b.y) + (b.z + b.w)) + ((c.x + c.y) + (c.z + c.w)) + ((d.x + d.y) + (d.z + d.w));
    return rsqrtf(t * (1.f / 1024.f) + 1e-6f);
}
struct EpiWin { static constexpr bool PERM = true; bf16_t* U; bf16_t* QKVC; const float* slots; const float* tab; const LAS float* rsl; int rs_pm;
    __device__ __forceinline__ bool keep(const Unit&) const { return false; }
    __device__ __forceinline__ void operator()(f32x4 (&acc)[2][2][4][2], const Unit& u, int wr, int wc, int fr, int fq) const {
        const int pn = u.pn, row0 = u.pm * 256 + wr * 64 + fr, colw = wc * 32 + 8 * fq;
        float cs = 1.f; if (pn < 4) cs = C2; else if (pn == 14 || pn == 15) cs = RSQ128;
        const bool rot = (pn >= 12 && pn < 16);
        f32x4 tq[2][2];
#define ROT_ISSUE(g, buf) do { const f32x4* tp_ = (const f32x4*)(tab + ((size_t)((row0 + ((g) >> 2) * 128 + ((g) & 3) * 16) & 2047) * 64 + (colw >> 1)) * 2); tq[buf][0] = tp_[0]; tq[buf][1] = tp_[1]; } while (0)
        tq[0][0] = (f32x4){1.f, 0.f, 1.f, 0.f}; tq[0][1] = tq[0][0]; tq[1][0] = tq[0][0]; tq[1][1] = tq[0][0];
        if (rot) ROT_ISSUE(0, 0);
#pragma unroll
        for (int g = 0; g < 8; ++g) { const int ai = g >> 2, m = g & 3;
            { const int row = row0 + ai * 128 + m * 16; const float rs = ((u.pm & ~4) == rs_pm ? rsl[((u.pm >> 2) & 1) * 256 + wr * 64 + fr + ai * 128 + m * 16] : slot_rstd(slots, row)) * cs;
                if (rot && g + 1 < 8) ROT_ISSUE(g + 1, (g + 1) & 1);
                const f32x4 t0 = tq[g & 1][0], t1 = tq[g & 1][1];
#pragma unroll
                for (int bj = 0; bj < 2; ++bj) { f32x4 v0 = acc[ai][bj][m][0] * rs, v1 = acc[ai][bj][m][1] * rs;
                    if (rot) { const f32x4 a0 = v0, a1 = v1;
                        v0.x = a0.x * t0.x - a0.y * t0.y; v0.y = a0.y * t0.x + a0.x * t0.y; v0.z = a0.z * t0.z - a0.w * t0.w; v0.w = a0.w * t0.z + a0.z * t0.w;
                        v1.x = a1.x * t1.x - a1.y * t1.y; v1.y = a1.y * t1.x + a1.x * t1.y; v1.z = a1.z * t1.z - a1.w * t1.w; v1.w = a1.w * t1.z + a1.z * t1.w; }
                    u32x4 w; w.x = pk2(v0.x, v0.y); w.y = pk2(v0.z, v0.w); w.z = pk2(v1.x, v1.y); w.w = pk2(v1.z, v1.w);
                    bf16_t* dst;
                    if (pn < 12) { const int hh = (pn & 3) * 2 + bj, c = colw >> 6, d = colw & 63, b = row >> 11, sq = row & 2047;
                        dst = QKVC + (size_t)(pn >> 2) * ((size_t)M * 1024) + ((size_t)((b * 8 + hh) * 2 + c) * 2048 + sq) * 64 + d; }
                    else dst = U + (size_t)row * INC + (pn - 12) * 256 + bj * 128 + colw;
                    *(u32x4*)dst = w; } } }
#undef ROT_ISSUE
    }
};
struct EpiResid { static constexpr bool PERM = true; const float* base; float* out; bf16_t* XB; float* slots;
    __device__ __forceinline__ bool keep(const Unit&) const { return false; }
    __device__ __forceinline__ void operator()(f32x4 (&acc)[2][2][4][2], const Unit& u, int wr, int wc, int fr, int fq) const {
        const int pn = u.pn, row0 = u.pm * 256 + wr * 64 + fr, colw = wc * 32 + 8 * fq;
        f32x4 r[4][4];
#define RES_ISSUE(g, buf) do { const size_t off_ = (size_t)(row0 + ((g) >> 2) * 128 + ((g) & 3) * 16) * D + pn * 256 + colw; \
        r[buf][0] = *(const f32x4*)(base + off_); r[buf][1] = *(const f32x4*)(base + off_ + 4); r[buf][2] = *(const f32x4*)(base + off_ + 128); r[buf][3] = *(const f32x4*)(base + off_ + 132); } while (0)
        RES_ISSUE(0, 0); RES_ISSUE(1, 1); RES_ISSUE(2, 2);
#pragma unroll
        for (int g = 0; g < 8; ++g) { const int ai = g >> 2, m = g & 3, row = row0 + ai * 128 + m * 16; float ss = 0.f;
            if (g + 3 < 8) RES_ISSUE(g + 3, (g + 3) & 3);
#pragma unroll
            for (int bj = 0; bj < 2; ++bj) { const size_t off = (size_t)row * D + pn * 256 + bj * 128 + colw;
                const f32x4 o0 = r[g & 3][2 * bj] + acc[ai][bj][m][0], o1 = r[g & 3][2 * bj + 1] + acc[ai][bj][m][1];
                *(f32x4*)(out + off) = o0; *(f32x4*)(out + off + 4) = o1;
                u32x4 w; w.x = pk2(o0.x, o0.y); w.y = pk2(o0.z, o0.w); w.z = pk2(o1.x, o1.y); w.w = pk2(o1.z, o1.w); *(u32x4*)(XB + off) = w;
                ss += (o0.x * o0.x + o0.y * o0.y) + (o0.z * o0.z + o0.w * o0.w) + (o1.x * o1.x + o1.y * o1.y) + (o1.z * o1.z + o1.w * o1.w); }
            ss += __shfl_xor(ss, 16); ss += __shfl_xor(ss, 32);
            if (fq == 0) slots[(size_t)row * 16 + pn * 4 + wc] = ss; }
#undef RES_ISSUE
    }
};
struct EpiW1 { static constexpr bool PERM = true; bf16_t* H; const float* slots; const LAS float* rsl; int rs_pm;
    __device__ __forceinline__ bool keep(const Unit&) const { return false; }
    __device__ __forceinline__ void operator()(f32x4 (&acc)[2][2][4][2], const Unit& u, int wr, int wc, int fr, int fq) const {
        const int pn = u.pn, row0 = u.pm * 256 + wr * 64 + fr, colw = wc * 32 + 8 * fq;
#pragma unroll
        for (int ai = 0; ai < 2; ++ai)
#pragma unroll
            for (int m = 0; m < 4; ++m) { const int row = row0 + ai * 128 + m * 16; const float rs = (u.pm & ~4) == rs_pm ? rsl[((u.pm >> 2) & 1) * 256 + wr * 64 + fr + ai * 128 + m * 16] : slot_rstd(slots, row);
#pragma unroll
                for (int bj = 0; bj < 2; ++bj) { f32x4 v0 = acc[ai][bj][m][0] * rs, v1 = acc[ai][bj][m][1] * rs;
                    v0 = __builtin_elementwise_max(v0, (f32x4){0.f, 0.f, 0.f, 0.f}); v1 = __builtin_elementwise_max(v1, (f32x4){0.f, 0.f, 0.f, 0.f}); v0 = v0 * v0; v1 = v1 * v1;
                    u32x4 w; w.x = pk2(v0.x, v0.y); w.y = pk2(v0.z, v0.w); w.z = pk2(v1.x, v1.y); w.w = pk2(v1.z, v1.w);
                    *(u32x4*)(H + (size_t)(row >> 11) * UBS + (size_t)(row & 2047) * FF + pn * 256 + bj * 128 + colw) = w; } }
    }
};
struct EpiXA { static constexpr bool PERM = true; bf16_t* QX; bf16_t* KX; bf16_t* VXT; const float* slots; const float* rsm; const LAS float* rsl;
    __device__ __forceinline__ bool keep(const Unit&) const { return false; }
    __device__ __forceinline__ void operator()(f32x4 (&acc)[2][2][4][2], const Unit& u, int wr, int wc, int fr, int fq) const {
        const int pn = u.pn, row0 = u.pm * 256 + wr * 64 + fr, colw = wc * 32 + 8 * fq, aux = u.aux;
        float rs[8]; f32x4 cv[2][2];
#pragma unroll
        for (int g = 0; g < 8; ++g) { const int row = row0 + (g >> 2) * 128 + (g & 3) * 16; rs[g] = aux == 0 ? rsl[wr * 64 + fr + (g >> 2) * 128 + (g & 3) * 16] * CQ : aux == 1 ? rsm[row] : 1.f; }
#pragma unroll
        for (int bj = 0; bj < 2; ++bj) { const int col = pn * 256 + bj * 128 + colw; cv[bj][0] = (f32x4){1.f, 1.f, 1.f, 1.f}; cv[bj][1] = cv[bj][0];
            if (aux == 2) { cv[bj][0] = *(const f32x4*)(rsm + col); cv[bj][1] = *(const f32x4*)(rsm + col + 4); } }
#pragma unroll
        for (int g = 0; g < 8; ++g) { const int ai = g >> 2, m = g & 3, row = row0 + ai * 128 + m * 16;
#pragma unroll
            for (int bj = 0; bj < 2; ++bj) { const int col = pn * 256 + bj * 128 + colw; const f32x4 v0 = acc[ai][bj][m][0] * rs[g] * cv[bj][0], v1 = acc[ai][bj][m][1] * rs[g] * cv[bj][1];
                u32x4 w; w.x = pk2(v0.x, v0.y); w.y = pk2(v0.z, v0.w); w.z = pk2(v1.x, v1.y); w.w = pk2(v1.z, v1.w);
                bf16_t* dst = aux == 0 ? QX + (size_t)row * 512 + col : aux == 1 ? KX + (size_t)row * 512 + col : VXT + (size_t)row * 2048 + col;
                *(u32x4*)dst = w; } }
    }
};
struct EpiBranch { static constexpr bool PERM = true; const bf16_t* U; bf16_t* MG;
    __device__ __forceinline__ bool keep(const Unit& u) const { return u.aux < 2; }
    __device__ __forceinline__ void operator()(f32x4 (&acc)[2][2][4][2], const Unit& u, int wr, int wc, int fr, int fq) const {
        const int pn = u.pn, row0 = u.pm * 256 + wr * 64 + fr, colw = wc * 32 + 8 * fq, j = u.aux;
        if (j < 2) {
            u32x4 gm[2][4];
#define BRM_ISSUE(g, buf) do { const bf16_t* gp_ = U + (size_t)(row0 + ((g) >> 2) * 128 + ((g) & 3) * 16) * INC + C_GT + j * 1024 + pn * 256 + colw; \
            gm[buf][0] = *(const u32x4*)gp_; gm[buf][1] = *(const u32x4*)(gp_ + 1024); gm[buf][2] = *(const u32x4*)(gp_ + 128); gm[buf][3] = *(const u32x4*)(gp_ + 128 + 1024); } while (0)
            BRM_ISSUE(0, 0);
#pragma unroll
            for (int g = 0; g < 8; ++g) { const int ai = g >> 2, m = g & 3;
                if (g + 1 < 8) BRM_ISSUE(g + 1, (g + 1) & 1);
#pragma unroll
                for (int bj = 0; bj < 2; ++bj) { const u32x4 g0 = gm[g & 1][2 * bj], g1 = gm[g & 1][2 * bj + 1]; f32x4 s0, s1;
#define RT(a, b) ((1.f + __expf(-(b))) * __builtin_amdgcn_rcpf(1.f + __expf(-(a))))
                    s0.x = RT(bflo(g0.x), bflo(g1.x)); s0.y = RT(bfhi(g0.x), bfhi(g1.x)); s0.z = RT(bflo(g0.y), bflo(g1.y)); s0.w = RT(bfhi(g0.y), bfhi(g1.y));
                    s1.x = RT(bflo(g0.z), bflo(g1.z)); s1.y = RT(bfhi(g0.z), bfhi(g1.z)); s1.z = RT(bflo(g0.w), bflo(g1.w)); s1.w = RT(bfhi(g0.w), bfhi(g1.w));
#undef RT
                    acc[ai][bj][m][0] = acc[ai][bj][m][0] * s0; acc[ai][bj][m][1] = acc[ai][bj][m][1] * s1; }
                asm volatile("" ::: "memory"); }
#undef BRM_ISSUE
        } else {
            u32x4 gq[2][2];
#define BR_ISSUE(g, buf) do { const bf16_t* gp_ = U + (size_t)(row0 + ((g) >> 2) * 128 + ((g) & 3) * 16) * INC + C_GT + 2 * 1024 + pn * 256 + colw; gq[buf][0] = *(const u32x4*)gp_; gq[buf][1] = *(const u32x4*)(gp_ + 128); } while (0)
            BR_ISSUE(0, 0);
#pragma unroll
            for (int g = 0; g < 8; ++g) { const int ai = g >> 2, m = g & 3, row = row0 + ai * 128 + m * 16;
                if (g + 1 < 8) BR_ISSUE(g + 1, (g + 1) & 1);
#pragma unroll
                for (int bj = 0; bj < 2; ++bj) { const int col = pn * 256 + bj * 128 + colw; const u32x4 g0 = gq[g & 1][bj]; f32x4 s0, s1;
                    s0.x = sigmoidf_(bflo(g0.x)); s0.y = sigmoidf_(bfhi(g0.x)); s0.z = sigmoidf_(bflo(g0.y)); s0.w = sigmoidf_(bfhi(g0.y));
                    s1.x = sigmoidf_(bflo(g0.z)); s1.y = sigmoidf_(bfhi(g0.z)); s1.z = sigmoidf_(bflo(g0.w)); s1.w = sigmoidf_(bfhi(g0.w));
                    const f32x4 v0 = acc[ai][bj][m][0] * s0, v1 = acc[ai][bj][m][1] * s1;
                    u32x4 w; w.x = pk2(v0.x, v0.y); w.y = pk2(v0.z, v0.w); w.z = pk2(v1.x, v1.y); w.w = pk2(v1.z, v1.w);
                    *(u32x4*)(MG + (size_t)(row >> 11) * MBS + (size_t)(row & 2047) * D + col) = w; } }
#undef BR_ISSUE
        }
    }
};

__device__ __forceinline__ void transpose_item(const float* W, const float* g, int K, int N, bf16_t* WT, int row_off, LAS float* scr, int item, int lane) {
    const int nblk = N / 64, kb = item / nblk, nb = item % nblk, k0 = 64 * kb, n0 = 64 * nb;
    f32x4 wv[16]; float gv[16];
#pragma unroll
    for (int i = 0; i < 16; ++i) { const int kk = 4 * i + (lane >> 4), nn = (lane & 15) * 4; gv[i] = g ? g[k0 + kk] : 1.f; wv[i] = *(const f32x4*)(W + (size_t)(k0 + kk) * N + n0 + nn); }
    asm volatile("" ::: "memory");
#pragma unroll
    for (int i = 0; i < 16; ++i) { const int kk = 4 * i + (lane >> 4), nn = (lane & 15) * 4; const f32x4 v = wv[i] * gv[i]; LAS float* d = scr + kk * 65 + nn; d[0] = v.x; d[1] = v.y; d[2] = v.z; d[3] = v.w; }
    asm volatile("s_waitcnt lgkmcnt(0)" ::: "memory");
    const int c = lane & 7;
#pragma unroll
    for (int j = 0; j < 8; ++j) { const int n = (lane >> 3) + 8 * j; const LAS float* s = scr + (8 * c) * 65 + n;
        u32x4 o; o.x = pk2(s[0 * 65], s[1 * 65]); o.y = pk2(s[2 * 65], s[3 * 65]); o.z = pk2(s[4 * 65], s[5 * 65]); o.w = pk2(s[6 * 65], s[7 * 65]);
        *(u32x4*)(WT + (size_t)(row_off + n0 + n) * K + k0 + 8 * c) = o; }
    asm volatile("s_waitcnt lgkmcnt(0)" ::: "memory");
}
__device__ __forceinline__ float row_to_bf16(const float* xrow, bf16_t* orow, int lane) {
    const f32x4* xr = (const f32x4*)xrow + lane; f32x4 v[4]; float s = 0.f;
#pragma unroll
    for (int j = 0; j < 4; ++j) { v[j] = xr[64 * j]; s += (v[j].x * v[j].x + v[j].y * v[j].y) + (v[j].z * v[j].z + v[j].w * v[j].w); }
    u32x2* o8 = (u32x2*)orow + lane;
#pragma unroll
    for (int j = 0; j < 4; ++j) { u32x2 w; w.x = pk2(v[j].x, v[j].y); w.y = pk2(v[j].z, v[j].w); o8[64 * j] = w; }
    return wave_sum(s);
}

__device__ __forceinline__ void conv_set(kaptr_t ka, GAS1 unsigned char* ws, int l, int set, int gwi, int ngw, LAS float* scr, int lane) {
    constexpr int I_IN = 16 * 176, I_SQ = 256, I_Q = 128, I_KV = 256, I_O = 128, I_1 = 1024, I_2 = 1024, I_L = 4;
    const int nit = set == 0 ? I_IN : set == 1 ? (3 * I_SQ + I_SQ + I_Q + I_KV + 16 * I_L) : (I_O + I_1 + I_2);
#pragma unroll 1
    for (int it = gwi; it < nit; it += ngw) {
        int r = it; const float* W; const float* g = nullptr; int K = 1024, N = 1024, ro = 0; bf16_t* WT;
        if (set == 0) { W = PIN(3) + (size_t)l * 1024 * 11264; g = PIN(2) + l * 1024; N = 11264; WT = WSP(bf16_t, WS_WIN); }
        else if (set == 1) {
            if (r < 3 * I_SQ) { const int j = r / I_SQ; r -= j * I_SQ; W = PIN(16) + (size_t)(l * 3 + j) * 1024 * 1024; WT = WSP(bf16_t, WS_WBR); ro = j * 1024; }
            else if ((r -= 3 * I_SQ) < I_SQ) { W = PIN(17) + (size_t)l * 1024 * 1024; WT = WSP(bf16_t, WS_WOUT); }
            else if ((r -= I_SQ) < I_Q) { W = PIN(20) + (size_t)l * 1024 * 512; g = PIN(18) + l * 1024; N = 512; WT = WSP(bf16_t, WS_WQ); }
            else if ((r -= I_Q) < I_KV) { W = PIN(21) + (size_t)l * 1024 * 1024; g = PIN(19) + l * 1024; WT = WSP(bf16_t, WS_WKV); }
            else { r -= I_KV; const int blk = r / I_L, which = blk >> 3, n = blk & 7; r -= blk * I_L; W = (which ? PIN(13) : PIN(11)) + (size_t)(l * 8 + n) * 16384; K = 128; N = 128; WT = WSP(bf16_t, WS_LRUW) + (size_t)blk * 16384; }
        } else {
            if (r < I_O) { W = PIN(22) + (size_t)l * 512 * 1024; K = 512; WT = WSP(bf16_t, WS_WO); }
            else if ((r -= I_O) < I_1) { W = PIN(24) + (size_t)l * 1024 * 4096; g = PIN(23) + l * 1024; N = 4096; WT = WSP(bf16_t, WS_W1); }
            else { r -= I_1; W = PIN(25) + (size_t)l * 4096 * 1024; K = 4096; WT = WSP(bf16_t, WS_W2); }
        }
        transpose_item(W, g, K, N, WT, ro, scr, r, lane);
    }
}

__device__ __forceinline__ void ret_state_unit(const bf16_t* U, bf16_t* ST, int unit, LAS unsigned char* lds, int tid, int lane, int wave) {
    const int es = unit & 3, bh = unit >> 2, h = bh & 3, b = bh >> 2;
    const float lg = log2f(1.f - exp2f(-5.f - (float)h)), cdec = exp2f(128.f * lg);
    LAS unsigned char* Kc = lds; LAS unsigned char* Vc = lds + 34816;
    const int dt = wave & 3, et = wave >> 2, r32 = lane & 31, hi = lane >> 5, g = lane >> 4, q4 = (lane & 15) >> 2, p4 = lane & 3;
    f32x16 st = {};
    const bf16_t* Ub = U + (size_t)b * S * INC;
    u32x4 pk_[4], pv_[2];
#define RS_FETCH(nn) do { _Pragma("unroll") for (int i = 0; i < 4; ++i) { const int idx = tid + i * 512; pk_[i] = *(const u32x4*)(Ub + (size_t)((nn) * 128 + (idx >> 4)) * INC + C_RK + h * 128 + (idx & 15) * 8); } \
        _Pragma("unroll") for (int i = 0; i < 2; ++i) { const int idx = tid + i * 512; pv_[i] = *(const u32x4*)(Ub + (size_t)((nn) * 128 + (idx >> 3)) * INC + C_RV + h * 256 + es * 64 + (idx & 7) * 8); } } while (0)
    RS_FETCH(0);
#pragma unroll 1
    for (int n = 0; n < 16; ++n) {
        __syncthreads();
#pragma unroll
        for (int i = 0; i < 4; ++i) { const int idx = tid + i * 512; *(LAS u32x4*)(Kc + (idx >> 4) * 272 + (idx & 15) * 16) = pk_[i]; }
#pragma unroll
        for (int i = 0; i < 2; ++i) { const int idx = tid + i * 512, r = idx >> 3, ch = idx & 7; const u32x4 v = pv_[i]; const float w = exp2f((float)(127 - r) * lg);
            u32x4 o; o.x = pk2(bflo(v.x) * w, bfhi(v.x) * w); o.y = pk2(bflo(v.y) * w, bfhi(v.y) * w); o.z = pk2(bflo(v.z) * w, bfhi(v.z) * w); o.w = pk2(bflo(v.w) * w, bfhi(v.w) * w);
            *(LAS u32x4*)(Vc + r * 144 + ch * 16) = o; }
        __syncthreads();
        if (n < 15) RS_FETCH(n + 1);
        bf16_t* sp = ST + ((size_t)(bh * 16 + n) * 256 + es * 64 + et * 32 + r32) * 128 + dt * 32 + 4 * hi;
#pragma unroll
        for (int g4 = 0; g4 < 4; ++g4) { u32x2 w; w.x = pk2(st[4 * g4], st[4 * g4 + 1]); w.y = pk2(st[4 * g4 + 2], st[4 * g4 + 3]); *(u32x2*)(sp + 8 * g4) = w; }
        f32x16 kv = {};
#pragma unroll
        for (int kk = 0; kk < 8; ++kk) {
            const LAS unsigned char* ka = Kc + (16 * kk + 8 * hi + q4) * 272 + (dt * 32 + 16 * (g & 1) + 4 * p4) * 2;
            const bf16x8 a = cat8(ldtr(ka), ldtr(ka + 4 * 272));
            const LAS unsigned char* va = Vc + (16 * kk + 8 * hi + q4) * 144 + (et * 32 + 16 * (g & 1) + 4 * p4) * 2;
            const bf16x8 bb = cat8(ldtr(va), ldtr(va + 4 * 144));
            kv = MFMA32(a, bb, kv); }
        st = st * cdec + kv;
    }
#undef RS_FETCH
}
__device__ __forceinline__ void ret_out_unit(const bf16_t* U, const bf16_t* ST, bf16_t* BR1, int unit, LAS unsigned char* lds, int tid, int lane_, int wave) {
    asm volatile("" : "+v"(tid)); const int lane = tid & 63; (void)lane_;
    const int n = unit & 15, bh = unit >> 4, h = bh & 3, b = bh >> 2;
    const float lg = log2f(1.f - exp2f(-5.f - (float)h));
    LAS unsigned char* Qs = lds; LAS unsigned char* Ks = lds + 34816; LAS unsigned char* Vs = lds + 69632;
    const int r32 = lane & 31, hi = lane >> 5, g = lane >> 4, q4 = (lane & 15) >> 2, p4 = lane & 3;
    const size_t tok0 = (size_t)b * S + n * 128;
    __syncthreads();
    load_tile<128, 128>(Qs, 272, U + tok0 * INC + C_RQ + h * 128, INC, tid); __builtin_amdgcn_sched_barrier(0);
    load_tile<128, 128>(Ks, 272, U + tok0 * INC + C_RK + h * 128, INC, tid); __builtin_amdgcn_sched_barrier(0);
    load_tile<128, 256>(Vs, 528, U + tok0 * INC + C_RV + h * 256, INC, tid);
    __syncthreads();
    const int ct = wave & 3, mt0 = (wave >> 2) * 2;
    f32x16 s[2]; s[0] = (f32x16){}; s[1] = (f32x16){};
#pragma unroll
    for (int j = 0; j < 2; ++j) { const int mt = mt0 + j;
        if (mt <= ct) {
#pragma unroll
            for (int kk = 0; kk < 8; ++kk) { const bf16x8 a = *(const LAS bf16x8*)(Qs + (ct * 32 + r32) * 272 + (16 * kk + 8 * hi) * 2);
                const bf16x8 bb = *(const LAS bf16x8*)(Ks + (mt * 32 + r32) * 272 + (16 * kk + 8 * hi) * 2); s[j] = MFMA32(a, bb, s[j]); __builtin_amdgcn_sched_barrier(0); } } }
    __syncthreads();
#pragma unroll
    for (int j = 0; j < 2; ++j) { const int mt = mt0 + j;
#pragma unroll
        for (int r = 0; r < 16; ++r) { const int c = ct * 32 + crow(r, hi), m = mt * 32 + r32, dl = c - m; const float val = dl >= 0 ? s[j][r] * exp2f((float)dl * lg) : 0.f;
            *(LAS bf16_t*)(Ks + c * 272 + m * 2) = f2bf(val); } }
#pragma unroll
    for (int i = 0; i < 4; ++i) { const int idx = tid + i * 512, r = idx >> 4, ch = idx & 15; const float w = exp2f((float)(r + 1) * lg);
        LAS u32x4* qp = (LAS u32x4*)(Qs + r * 272 + ch * 16); const u32x4 v = *qp;
        u32x4 o; o.x = pk2(bflo(v.x) * w, bfhi(v.x) * w); o.y = pk2(bflo(v.y) * w, bfhi(v.y) * w); o.z = pk2(bflo(v.z) * w, bfhi(v.z) * w); o.w = pk2(bflo(v.w) * w, bfhi(v.w) * w); *qp = o; }
    __syncthreads();
    f32x16 oi[4];
#pragma unroll
    for (int c4 = 0; c4 < 4; ++c4) oi[c4] = (f32x16){};
    const bf16_t* stp = ST + ((size_t)unit * 256 + 32 * wave + r32) * 128 + 8 * hi;
#pragma unroll
    for (int kk = 0; kk < 8; ++kk) { const LAS unsigned char* va = Vs + (16 * kk + 8 * hi + q4) * 528 + (32 * wave + 16 * (g & 1) + 4 * p4) * 2;
        const bf16x8 bb = cat8(ldtr(va), ldtr(va + 4 * 528));
#pragma unroll
        for (int c4 = 0; c4 < 4; ++c4) { const bf16x8 a = *(const LAS bf16x8*)(Ks + (c4 * 32 + r32) * 272 + (16 * kk + 8 * hi) * 2); oi[c4] = MFMA32(a, bb, oi[c4]); } __builtin_amdgcn_sched_barrier(0); }
#pragma unroll
    for (int k4 = 0; k4 < 8; k4 += 4) { bf16x8 stf[4];
#pragma unroll
        for (int kq = 0; kq < 4; ++kq) stf[kq] = *(const bf16x8*)(stp + 16 * (k4 + kq));
#pragma unroll
        for (int kq = 0; kq < 4; ++kq) { const int kk = k4 + kq;
#pragma unroll
            for (int c4 = 0; c4 < 4; ++c4) { const bf16x8 a = *(const LAS bf16x8*)(Qs + (c4 * 32 + r32) * 272 + (16 * kk + 8 * hi) * 2); oi[c4] = MFMA32(a, stf[kq], oi[c4]); } }
        __builtin_amdgcn_sched_barrier(0); }
    __syncthreads();
    LAS unsigned char* Of = lds;
#pragma unroll
    for (int c4 = 0; c4 < 4; ++c4)
#pragma unroll
        for (int r = 0; r < 16; ++r) { const int c = c4 * 32 + crow(r, hi); *(LAS float*)(Of + c * 1040 + (32 * wave + r32) * 4) = oi[c4][r]; }
    __syncthreads();
    { const int row = tid >> 2, qd = tid & 3; f32x4 v[16]; float sm = 0.f;
      const bf16_t* rgp = U + (tok0 + row) * INC + C_RG + h * 256 + qd * 64; u32x4 gvv[8];
#pragma unroll
      for (int k = 0; k < 8; ++k) gvv[k] = *(const u32x4*)(rgp + ((k + 2 * qd) & 7) * 8);
#pragma unroll
      for (int i = 0; i < 16; ++i) { const int ch = (i + 4 * qd) & 15; v[i] = *(const LAS f32x4*)(Of + row * 1040 + qd * 256 + ch * 16); sm += (v[i].x + v[i].y) + (v[i].z + v[i].w); }
      sm += __shfl_xor(sm, 1); sm += __shfl_xor(sm, 2); const float mean = sm * (1.f / 256.f); float q = 0.f;
#pragma unroll
      for (int i = 0; i < 16; ++i) { v[i] = v[i] - mean; q += (v[i].x * v[i].x + v[i].y * v[i].y) + (v[i].z * v[i].z + v[i].w * v[i].w); }
      q += __shfl_xor(q, 1); q += __shfl_xor(q, 2); const float rstd = rsqrtf(q * (1.f / 256.f) + 1e-5f);
      bf16_t* op = BR1 + (tok0 + row) * D + h * 256 + qd * 64;
#pragma unroll
      for (int k = 0; k < 8; ++k) { const int grp = (k + 2 * qd) & 7; const u32x4 gv = gvv[k]; const f32x4 a = v[2 * k] * rstd, c = v[2 * k + 1] * rstd;
#define SILU(x) ((x) * sigmoidf_(x))
          u32x4 w; w.x = pk2(SILU(bflo(gv.x)) * a.x, SILU(bfhi(gv.x)) * a.y); w.y = pk2(SILU(bflo(gv.y)) * a.z, SILU(bfhi(gv.y)) * a.w);
          w.z = pk2(SILU(bflo(gv.z)) * c.x, SILU(bfhi(gv.z)) * c.y); w.w = pk2(SILU(bflo(gv.w)) * c.z, SILU(bfhi(gv.w)) * c.w);
#undef SILU
          *(u32x4*)(op + grp * 8) = w; __builtin_amdgcn_sched_barrier(0); } }
}

template <bool FINAL> __device__ __forceinline__ void lru_unit(kaptr_t ka, int l, const bf16_t* U, float2* CARRY, bf16_t* BR2, const bf16_t* LW, int unit, LAS unsigned char* lds, int tid, int lane, int wave) {
    const int n = unit & 7, tc = (unit >> 3) & 15, b = unit >> 7;
    LAS unsigned char* Xc = lds; LAS unsigned char* Wa = lds + 34816; LAS unsigned char* Wx = lds + 69632;
    LAS unsigned char* A_ = lds; LAS unsigned char* B_ = lds + 67584; LAS f32x2* SEG = (LAS f32x2*)(lds + 135168);
    const size_t tok0 = (size_t)b * S + tc * 128;
    const int r32 = lane & 31, hi = lane >> 5;
    __syncthreads();
    load_tile<128, 128>(Wa, 272, LW + (size_t)n * 16384, 128, tid);
    load_tile<128, 128>(Wx, 272, LW + (size_t)(8 + n) * 16384, 128, tid);
    { const float* cw = PIN(9) + (size_t)l * 4096; const float* cb = PIN(10) + (size_t)l * 1024;
#pragma unroll
      for (int i = 0; i < 4; ++i) { const int idx = tid + i * 512, t = idx >> 4, c0 = n * 128 + (idx & 15) * 8;
          f32x4 a0 = *(const f32x4*)(cb + c0), a1 = *(const f32x4*)(cb + c0 + 4);
#pragma unroll
          for (int j = 0; j < 4; ++j) { const int ts = tc * 128 + t - 3 + j;
              if (ts >= 0) { const u32x4 xv = *(const u32x4*)(U + ((size_t)b * S + ts) * INC + C_LX + c0); const f32x4 w0 = *(const f32x4*)(cw + j * 1024 + c0), w1 = *(const f32x4*)(cw + j * 1024 + c0 + 4);
                  a0.x += w0.x * bflo(xv.x); a0.y += w0.y * bfhi(xv.x); a0.z += w0.z * bflo(xv.y); a0.w += w0.w * bfhi(xv.y);
                  a1.x += w1.x * bflo(xv.z); a1.y += w1.y * bfhi(xv.z); a1.z += w1.z * bflo(xv.w); a1.w += w1.w * bfhi(xv.w); } }
          u32x4 o; o.x = pk2(a0.x, a0.y); o.y = pk2(a0.z, a0.w); o.z = pk2(a1.x, a1.y); o.w = pk2(a1.z, a1.w);
          *(LAS u32x4*)(Xc + t * 272 + (idx & 15) * 16) = o; } }
    __syncthreads();
    const int tt = wave & 3, dt0 = (wave >> 2) * 2;
    f32x16 ra[2], ia[2]; ra[0] = (f32x16){}; ra[1] = (f32x16){}; ia[0] = (f32x16){}; ia[1] = (f32x16){};
#pragma unroll
    for (int kk = 0; kk < 8; ++kk) { const bf16x8 a = *(const LAS bf16x8*)(Xc + (tt * 32 + r32) * 272 + (16 * kk + 8 * hi) * 2);
#pragma unroll
        for (int j = 0; j < 2; ++j) { const int ro = ((dt0 + j) * 32 + r32) * 272 + (16 * kk + 8 * hi) * 2;
            ra[j] = MFMA32(a, *(const LAS bf16x8*)(Wa + ro), ra[j]); ia[j] = MFMA32(a, *(const LAS bf16x8*)(Wx + ro), ia[j]); } }
#pragma unroll
    for (int j = 0; j < 2; ++j) { const int ch = (dt0 + j) * 32 + r32, gch = l * 1024 + n * 128 + ch;
        const float ba = PIN(12)[gch], bx = PIN(14)[gch], sp = __logf(1.f + __expf(-PIN(15)[gch]));
#pragma unroll
        for (int r = 0; r < 16; ++r) { const int t = tt * 32 + crow(r, hi); const float xc = bf2f(*(const LAS bf16_t*)(Xc + t * 272 + ch * 2));
            const float rr = sigmoidf_(ra[j][r] + ba), ii = sigmoidf_(ia[j][r] + bx), la = -8.f * rr * sp, av = __expf(la), mult = sqrtf(fmaxf(1.f - __expf(2.f * la), 0.f));
            ra[j][r] = av; ia[j][r] = mult * ii * xc; } }
    __syncthreads();
#pragma unroll
    for (int j = 0; j < 2; ++j) { const int ch = (dt0 + j) * 32 + r32;
#pragma unroll
        for (int r = 0; r < 16; ++r) { const int t = tt * 32 + crow(r, hi); *(LAS float*)(A_ + t * 528 + ch * 4) = ra[j][r]; *(LAS float*)(B_ + t * 528 + ch * 4) = ia[j][r]; } }
    __syncthreads();
    const int ch = tid & 127, seg = tid >> 7;
    { float Ac = 1.f, Bc = 0.f;
      for (int t = seg * 32; t < seg * 32 + 32; ++t) { const float av = *(const LAS float*)(A_ + t * 528 + ch * 4), bv = *(const LAS float*)(B_ + t * 528 + ch * 4); Bc = av * Bc + bv; Ac *= av; }
      SEG[seg * 128 + ch] = (f32x2){Ac, Bc}; }
    __syncthreads();
    if (!FINAL) {
        if (seg == 0) { float A = 1.f, hh = 0.f;
#pragma unroll
            for (int s2 = 0; s2 < 4; ++s2) { const f32x2 c = SEG[s2 * 128 + ch]; hh = c.x * hh + c.y; A *= c.x; }
            CARRY[(size_t)(b * 16 + tc) * 1024 + n * 128 + ch] = make_float2(A, hh); }
    } else {
        float hh = 0.f;
        for (int j = 0; j < tc; ++j) { const float2 c = CARRY[(size_t)(b * 16 + j) * 1024 + n * 128 + ch]; hh = c.x * hh + c.y; }
        for (int s2 = 0; s2 < seg; ++s2) { const f32x2 c = SEG[s2 * 128 + ch]; hh = c.x * hh + c.y; }
        for (int t = seg * 32; t < seg * 32 + 32; ++t) { const float av = *(const LAS float*)(A_ + t * 528 + ch * 4), bv = *(const LAS float*)(B_ + t * 528 + ch * 4); hh = av * hh + bv;
            const float y = bf2f(U[(tok0 + t) * INC + C_LY + n * 128 + ch]); const float u3 = 0.7978845608028654f * (y + 0.044715f * y * y * y);
            const float ge = y * (1.f - 1.f / (1.f + __expf(2.f * u3)));
            BR2[(tok0 + t) * D + n * 128 + ch] = f2bf(hh * ge); }
    }
}

__device__ __forceinline__ void lru_seq_unit(kaptr_t ka, int l, const bf16_t* U, bf16_t* BR2, const bf16_t* LW, int unit, LAS unsigned char* lds, int tid, int lane, int wave) {
    const int q = unit & 3, n = (unit >> 2) & 7, b = unit >> 5;
    LAS unsigned char* Xc = lds;
    LAS unsigned char* Wq = lds + 34816;
    LAS float* A_T = (LAS float*)(lds + 52224);
    LAS float* B_T = (LAS float*)(lds + 69120);
    LAS unsigned char* Yr = lds + 86016;
    LAS f32x2* SEG = (LAS f32x2*)(lds + 93184);
    LAS float* HC = (LAS float*)(lds + 97280);
    LAS unsigned char* OUTS = lds + 94208;
    LAS unsigned char* Xr = lds + 105728;
    const int r32 = lane & 31, hi = lane >> 5, tt = wave & 3, mat = wave >> 2;
    const int chq = n * 128 + q * 32;
    const bf16_t* Ub = U + (size_t)b * S * INC;
    __syncthreads();
    { const int r = tid >> 4, ch = tid & 15;
#pragma unroll
      for (int i = 0; i < 2; ++i) { const int rr = r + 32 * i, mm = rr >> 5;
          const u32x4 v = *(const u32x4*)(LW + (size_t)(mm * 8 + n) * 16384 + (size_t)(q * 32 + (rr & 31)) * 128 + ch * 8); *(LAS u32x4*)(Wq + rr * 272 + ch * 16) = v; } }
    const int c16 = tid & 15, cc0 = n * 128 + c16 * 8;
    f32x4 cwv[4][2], cbv[2];
    { const float* cw = PIN(9) + (size_t)l * 4096 + cc0; const float* cb = PIN(10) + (size_t)l * 1024 + cc0; cbv[0] = *(const f32x4*)cb; cbv[1] = *(const f32x4*)(cb + 4);
#pragma unroll
      for (int j = 0; j < 4; ++j) { cwv[j][0] = *(const f32x4*)(cw + j * 1024); cwv[j][1] = *(const f32x4*)(cw + j * 1024 + 4); } }
    const int gch = l * 1024 + chq + r32;
    const float bgate = mat ? PIN(14)[gch] : PIN(12)[gch], sp = __logf(1.f + __expf(-PIN(15)[gch]));
    u32x4 pf[7], pfy;
#define LRU_FETCH(tcn) do { _Pragma("unroll") for (int i = 0; i < 7; ++i) { const int ts = (tcn) * 128 - 3 + 4 * (tid >> 4) + i; \
        pf[i] = (u32x4){0u, 0u, 0u, 0u}; if (ts >= 0) pf[i] = *(const u32x4*)(Ub + (size_t)ts * INC + C_LX + cc0); } \
        pfy = *(const u32x4*)(Ub + (size_t)((tcn) * 128 + (tid >> 2)) * INC + C_LY + chq + (tid & 3) * 8); } while (0)
    LRU_FETCH(0);
    float hc = 0.f;
#pragma unroll 1
    for (int tc = 0; tc < 16; ++tc) {
        if (tc > 0) { const int t = tid >> 2, c8 = tid & 3; *(u32x4*)(BR2 + ((size_t)b * S + (tc - 1) * 128 + t) * D + chq + c8 * 8) = *(const LAS u32x4*)(OUTS + t * 64 + c8 * 16); }
        *(LAS u32x4*)(Yr + (tid >> 2) * 64 + (tid & 3) * 16) = pfy;
#pragma unroll
        for (int i = 0; i < 4; ++i) { const int t = 4 * (tid >> 4) + i; f32x4 a0 = cbv[0], a1 = cbv[1];
#pragma unroll
            for (int j = 0; j < 4; ++j) { const u32x4 xv = pf[i + j];
                a0.x += cwv[j][0].x * bflo(xv.x); a0.y += cwv[j][0].y * bfhi(xv.x); a0.z += cwv[j][0].z * bflo(xv.y); a0.w += cwv[j][0].w * bfhi(xv.y);
                a1.x += cwv[j][1].x * bflo(xv.z); a1.y += cwv[j][1].y * bfhi(xv.z); a1.z += cwv[j][1].z * bflo(xv.w); a1.w += cwv[j][1].w * bfhi(xv.w); }
            u32x4 o; o.x = pk2(a0.x, a0.y); o.y = pk2(a0.z, a0.w); o.z = pk2(a1.x, a1.y); o.w = pk2(a1.z, a1.w);
            *(LAS u32x4*)(Xc + t * 272 + c16 * 16) = o; }
        __syncthreads();
        if (tc < 15) LRU_FETCH(tc + 1);
        { f32x16 acc = (f32x16){};
#pragma unroll
          for (int kk = 0; kk < 8; ++kk) { const bf16x8 a = *(const LAS bf16x8*)(Xc + (tt * 32 + r32) * 272 + (16 * kk + 8 * hi) * 2);
              const bf16x8 bw = *(const LAS bf16x8*)(Wq + (mat * 32 + r32) * 272 + (16 * kk + 8 * hi) * 2); acc = MFMA32(a, bw, acc); }
          if (mat == 0) {
#pragma unroll
              for (int g4 = 0; g4 < 4; ++g4) { f32x4 v;
#pragma unroll
                  for (int e = 0; e < 4; ++e) v[e] = __expf(-8.f * sigmoidf_(acc[4 * g4 + e] + bgate) * sp);
                  *(LAS f32x4*)(A_T + r32 * 132 + tt * 32 + 8 * g4 + 4 * hi) = v; }
          } else {
#pragma unroll
              for (int g4 = 0; g4 < 4; ++g4) { f32x4 v;
#pragma unroll
                  for (int e = 0; e < 4; ++e) { const int t = tt * 32 + 8 * g4 + 4 * hi + e; const float xc = bf2f(*(const LAS bf16_t*)(Xc + t * 272 + (q * 32 + r32) * 2)); v[e] = sigmoidf_(acc[4 * g4 + e] + bgate) * xc; }
                  *(LAS f32x4*)(B_T + r32 * 132 + tt * 32 + 8 * g4 + 4 * hi) = v; }
          } }
        __syncthreads();
        { const int chl = lane & 3, seg = lane >> 2, chw = wave * 4 + chl;
          const f32x4 a0 = *(const LAS f32x4*)(A_T + chw * 132 + seg * 8), a1 = *(const LAS f32x4*)(A_T + chw * 132 + seg * 8 + 4);
          const f32x4 g0 = *(const LAS f32x4*)(B_T + chw * 132 + seg * 8), g1 = *(const LAS f32x4*)(B_T + chw * 132 + seg * 8 + 4);
          float av[8] = {a0.x, a0.y, a0.z, a0.w, a1.x, a1.y, a1.z, a1.w}, bv[8] = {g0.x, g0.y, g0.z, g0.w, g1.x, g1.y, g1.z, g1.w};
          float Ac = 1.f, Bc = 0.f;
#pragma unroll
          for (int t = 0; t < 8; ++t) { bv[t] = sqrtf(fmaxf(1.f - av[t] * av[t], 0.f)) * bv[t]; Bc = av[t] * Bc + bv[t]; Ac *= av[t]; }
#pragma unroll
          for (int d = 4; d < 64; d <<= 1) { const float Ap = __shfl_up(Ac, d), Bp = __shfl_up(Bc, d); if (lane >= d) { Bc = Ac * Bp + Bc; Ac = Ac * Ap; } }
          float Ae = __shfl_up(Ac, 4), Be = __shfl_up(Bc, 4); if (lane < 4) { Ae = 1.f; Be = 0.f; }
          float hh = Ae * hc + Be;
#pragma unroll
          for (int t = 0; t < 8; ++t) { hh = av[t] * hh + bv[t]; const float y = bf2f(*(const LAS bf16_t*)(Yr + (seg * 8 + t) * 64 + chw * 2));
              const float ge = y * (1.f - __builtin_amdgcn_rcpf(1.f + __expf(1.5957691216057308f * (y + 0.044715f * y * y * y))));
              *(LAS bf16_t*)(OUTS + (seg * 8 + t) * 64 + chw * 2) = f2bf(hh * ge); }
          hc = __shfl(hh, 60 + chl); }
        __syncthreads();
    }
    { const int t = tid >> 2, c8 = tid & 3; *(u32x4*)(BR2 + ((size_t)b * S + 15 * 128 + t) * D + chq + c8 * 8) = *(const LAS u32x4*)(OUTS + t * 64 + c8 * 16); }
#undef LRU_FETCH
}

__device__ __forceinline__ void xattn_unit(const bf16_t* QX, const bf16_t* KX, const bf16_t* VXT, bf16_t* OX, int unit, LAS unsigned char* lds, int tid, int lane, int wave) {
    const int qb = unit & 7, h = (unit >> 3) & 3, b = unit >> 5;
    LAS unsigned char* Ks = lds; LAS unsigned char* Vt = lds + 69632; LAS float* wsf = (LAS float*)(lds + 137216) + wave * 32;
    const int r32 = lane & 31, hi = lane >> 5;
    __syncthreads();
    load_tile<256, 128>(Ks, 272, KX + (size_t)b * 256 * 512 + h * 128, 512, tid);
    load_tile<128, 256>(Vt, 528, VXT + (size_t)h * 128 * 2048 + b * 256, 2048, tid);
    const size_t q0 = (size_t)b * S + qb * 256 + wave * 32;
    bf16x8 qf[8];
#pragma unroll
    for (int kk = 0; kk < 8; ++kk) qf[kk] = *(const bf16x8*)(QX + (q0 + r32) * 512 + h * 128 + kk * 16 + hi * 8);
    __syncthreads();
    float mx = -INFINITY;
#pragma unroll 1
    for (int half = 0; half < 2; ++half) {
        const LAS unsigned char* kb = Ks + (half * 128 + r32) * 272 + 16 * hi;
#pragma unroll
        for (int k4 = 0; k4 < 4; ++k4) { f32x16 sc = (f32x16){};
#pragma unroll
            for (int kk = 0; kk < 8; ++kk) { const bf16x8 a = *(const LAS bf16x8*)(kb + k4 * 32 * 272 + 32 * kk); sc = MFMA32(a, qf[kk], sc); }
#pragma unroll
            for (int r = 0; r < 16; ++r) mx = fmaxf(mx, sc[r]);
            __builtin_amdgcn_sched_barrier(0); }
    }
    mx = fmaxf(mx, __shfl_xor(mx, 32));
    float sum = 0.f;
    f32x16 o[4];
#pragma unroll
    for (int d4 = 0; d4 < 4; ++d4) o[d4] = (f32x16){};
#pragma unroll 1
    for (int half = 0; half < 2; ++half) {
        const LAS unsigned char* kb = Ks + (half * 128 + r32) * 272 + 16 * hi;
        const LAS unsigned char* vb = Vt + r32 * 528 + (half * 128 + 4 * hi) * 2;
#pragma unroll
        for (int k4 = 0; k4 < 4; ++k4) { f32x16 sc = (f32x16){};
#pragma unroll
            for (int kk = 0; kk < 8; ++kk) { const bf16x8 a = *(const LAS bf16x8*)(kb + k4 * 32 * 272 + 32 * kk); sc = MFMA32(a, qf[kk], sc); }
#pragma unroll
            for (int r = 0; r < 16; ++r) { const float e = exp2f(sc[r] - mx); sc[r] = e; sum += e; }
#pragma unroll
            for (int s2 = 0; s2 < 2; ++s2) {
                u32x4 pw; pw.x = pk2(sc[8 * s2 + 0], sc[8 * s2 + 1]); pw.y = pk2(sc[8 * s2 + 2], sc[8 * s2 + 3]); pw.z = pk2(sc[8 * s2 + 4], sc[8 * s2 + 5]); pw.w = pk2(sc[8 * s2 + 6], sc[8 * s2 + 7]);
                const bf16x8 a = __builtin_bit_cast(bf16x8, pw);
#pragma unroll
                for (int d4 = 0; d4 < 4; ++d4) { const LAS unsigned char* vp = vb + d4 * 32 * 528 + (32 * k4 + 16 * s2) * 2;
                    const s16x4 lo = *(const LAS s16x4*)vp, hh = *(const LAS s16x4*)(vp + 16); o[d4] = MFMA32(a, cat8(lo, hh), o[d4]); } }
            __builtin_amdgcn_sched_barrier(0); }
    }
    sum += __shfl_xor(sum, 32);
    if (hi == 0) wsf[r32] = 1.f / sum;
    asm volatile("s_waitcnt lgkmcnt(0)" ::: "memory");
    __builtin_amdgcn_wave_barrier();
#pragma unroll
    for (int r = 0; r < 16; ++r) { const float rl = wsf[crow(r, hi)]; bf16_t* op = OX + (q0 + crow(r, hi)) * 512 + h * 128 + r32;
#pragma unroll
        for (int d4 = 0; d4 < 4; ++d4) op[d4 * 32] = f2bf(o[d4][r] * rl); }
}

#define XB_TMO      128
#define XB_XCNT(j)  (256  + 64 * (j))
#define XB_XSUB(j)  (1280 + 64 * (j))
#define XB_XGEN(j)  (2304 + 64 * (j))
#define XB_TOP      3328
#define XB_TOPGEN   3392
#define XCD_BAR_WORDS 3456
#define XB_SPIN_CAP (1u << 18)

__device__ __forceinline__ unsigned xb_ld(unsigned* p)              { return __hip_atomic_load(p, __ATOMIC_RELAXED, __HIP_MEMORY_SCOPE_AGENT); }
__device__ __forceinline__ unsigned xb_add(unsigned* p, unsigned v) { return __hip_atomic_fetch_add(p, v, __ATOMIC_RELAXED, __HIP_MEMORY_SCOPE_AGENT); }
__device__ __forceinline__ unsigned xb_xcc_id() { return (unsigned)__builtin_amdgcn_s_getreg((3 << 11) | 20) & 0xFu; }
#define XB_SPIN(cond, bar) do { unsigned _sp = 0; while (cond) { __builtin_amdgcn_s_sleep(1); \
    if ((++_sp & 255u) == 0u) { if (xb_ld(&(bar)[XB_TMO])) break; if (_sp > XB_SPIN_CAP) { atomicAdd(&(bar)[XB_TMO], 1u); break; } } } } while (0)

struct XcdBarrier {
    unsigned* bar; unsigned x;
    volatile LAS unsigned* st;
};

__device__ __forceinline__ XcdBarrier xcd_barrier_post(unsigned* bar, volatile LAS unsigned* st, int tid_) {
    XcdBarrier b; b.bar = bar; b.x = xb_xcc_id(); b.st = st;
    if (tid_ == 0) (void)xb_add(&bar[XB_XCNT(b.x)], 1u);
    return b;
}
__device__ __forceinline__ void xcd_barrier_complete(unsigned* bar, unsigned x, unsigned& nloc, unsigned& nx) {
    const unsigned G = gridDim.x * gridDim.y * gridDim.z;
    unsigned sum, cnt, mine, sp = 0u;
    for (;;) {
        sum = 0u; cnt = 0u; mine = 0u;
#pragma unroll
        for (unsigned j = 0; j < 16; ++j) { const unsigned c = xb_ld(&bar[XB_XCNT(j)]); sum += c; cnt += (c > 0u) ? 1u : 0u; mine = (j == x) ? c : mine; }
        if (sum == G) break;
        __builtin_amdgcn_s_sleep(1);
        if ((++sp & 255u) == 0u) { if (xb_ld(&bar[XB_TMO])) break; if (sp > XB_SPIN_CAP) { atomicAdd(&bar[XB_TMO], 1u); break; } }
    }
    nloc = mine > 0u ? mine : 1u; nx = cnt > 0u ? cnt : 1u;
}

__device__ __forceinline__ void xcd_barrier(const XcdBarrier& b, int tid_) {
    asm volatile("s_waitcnt vmcnt(0)" ::: "memory");
    __syncthreads();
    if (tid_ == 0) {
        unsigned* bar = b.bar;
        __builtin_amdgcn_s_waitcnt(0);
        unsigned nloc = b.st[0], nx = b.st[1];
        if (nloc == 0u) { xcd_barrier_complete(bar, b.x, nloc, nx); b.st[0] = nloc; b.st[1] = nx; }
        const unsigned old = xb_add(&bar[XB_XSUB(b.x)], 1u);
        const unsigned gen = old / nloc;
        if (old + 1u == (gen + 1u) * nloc) {
            __builtin_amdgcn_fence(__ATOMIC_RELEASE, "agent");
            asm volatile("s_waitcnt vmcnt(0)" ::: "memory");
            const unsigned og = xb_add(&bar[XB_TOP], 1u);
            const unsigned tg = og / nx;
            if (og + 1u == (tg + 1u) * nx) xb_add(&bar[XB_TOPGEN], 1u);
            else XB_SPIN(xb_ld(&bar[XB_TOPGEN]) == tg, bar);
            __builtin_amdgcn_fence(__ATOMIC_ACQUIRE, "agent");
            xb_add(&bar[XB_XGEN(b.x)], 1u);
            asm volatile("s_waitcnt vmcnt(0)" ::: "memory");
        } else {
            XB_SPIN(xb_ld(&bar[XB_XGEN(b.x)]) == gen, bar);
            __builtin_amdgcn_fence(__ATOMIC_ACQUIRE, "agent");
            asm volatile("s_waitcnt vmcnt(0)" ::: "memory");
        }
    }
    __syncthreads();
}

#define XL_RANK(j) (8192 + 64 * (j))
#define XL_SUB(j)  (9216 + 64 * (j))
#define XL_GEN(j)  (10240 + 64 * (j))
__device__ __forceinline__ void xcd_local_barrier(unsigned* bar, unsigned x, int tid_) {
    asm volatile("s_waitcnt vmcnt(0)" ::: "memory");
    __syncthreads();
    if (tid_ == 0) {
        __builtin_amdgcn_s_waitcnt(0);
        const unsigned old = xb_add(&bar[XL_SUB(x)], 1u), gen = old >> 5;
        if ((old & 31u) == 31u) xb_add(&bar[XL_GEN(x)], 1u);
        else XB_SPIN(xb_ld(&bar[XL_GEN(x)]) == gen, bar);
        __builtin_amdgcn_fence(__ATOMIC_ACQUIRE, "agent");
        asm volatile("s_waitcnt vmcnt(0)" ::: "memory");
    }
    __syncthreads();
}

#define PH_BEGIN KA_GET(ka) int tid = tid_of(wave_s), G = gridDim.x, bx = bxv; GAS1 unsigned char* ws = PWS; asm volatile("" : "+s"(G), "+s"(bx), "+s"(ws)); \
    const int lane = tid & 63, wave = __builtin_amdgcn_readfirstlane(tid >> 6), vc = lok ? (bx & 7) * 32 + (bx >> 3) : bx; (void)lane; (void)wave; (void)vc;
#ifndef DUP_SYNC
#define DUP_SYNC 1
#endif
#ifndef DUP_P0
#define DUP_P0 1
#endif
#ifndef DUP_2A
#define DUP_2A 1
#endif
#ifndef DUP_AT
#define DUP_AT 1
#endif
#ifndef DUP_2B
#define DUP_2B 1
#endif
#ifndef DUP_G1
#define DUP_G1 1
#endif
#ifndef DUP_G3
#define DUP_G3 1
#endif
#ifndef DUP_G5
#define DUP_G5 1
#endif
#ifndef DUP_G8
#define DUP_G8 1
#endif
#ifndef DUP_LRU
#define DUP_LRU 1
#endif
#ifndef DUP_G4
#define DUP_G4 1
#endif
#ifndef DUP_G9
#define DUP_G9 1
#endif
#ifndef DUP_XA
#define DUP_XA 1
#endif
#define GSYNC() do { for (int q_ = 0; q_ < DUP_SYNC; ++q_) xcd_barrier(xbar, tid_of(wave_s)); } while (0)
#define LSYNC() do { if (lok) xcd_local_barrier(xbar.bar, xbar.x, tid_of(wave_s)); else xcd_barrier(xbar, tid_of(wave_s)); } while (0)
__global__ void __launch_bounds__(512, 2) fwd_megakernel(Params p) {
    extern __shared__ __attribute__((aligned(16))) unsigned char lds[];
    cg::grid_group grid = cg::this_grid();
    LAS unsigned char* L = (LAS unsigned char*)lds;
    const int wave_s = __builtin_amdgcn_readfirstlane(threadIdx.x >> 6);
    XcdBarrier xbar;
    { KA_GET(ka) volatile LAS unsigned* MISC = (volatile LAS unsigned*)(L + MISC_OFF); const int t0 = tid_of(wave_s);
      if (t0 < 2) MISC[t0] = 0u;
      __syncthreads();
      xbar = xcd_barrier_post((unsigned*)(GAS1 unsigned*)(PWS + 16384), MISC, t0);
      if (t0 == 0) MISC[2] = xb_add(&xbar.bar[XL_RANK(xbar.x)], 1u);
      __syncthreads(); }
    int bxv = blockIdx.x; unsigned lok = 0u;
    { PH_BEGIN
        const int gw = bx * 8 + wave, NGW = G * 8;
        {
                float* slots = WSP(float, WS_SLOT); float* rsm = WSP(float, WS_RSM); float* tab = WSP(float, WS_TAB);
                for (int m = gw; m < M; m += 2 * NGW) {
                    const int m2 = m + NGW; const f32x4* x0 = (const f32x4*)(PIN(0) + (size_t)m * D) + lane; const f32x4* x1 = (const f32x4*)(PIN(0) + (size_t)m2 * D) + lane; f32x4 a[4], b[4]; float s0 = 0.f, s1 = 0.f;
#pragma unroll
                    for (int j = 0; j < 4; ++j) { a[j] = x0[64 * j]; b[j] = x1[64 * j]; }
                    u32x2* o0 = (u32x2*)(WSP(bf16_t, WS_XB) + (size_t)m * D) + lane; u32x2* o1 = (u32x2*)(WSP(bf16_t, WS_XB) + (size_t)m2 * D) + lane;
#pragma unroll
                    for (int j = 0; j < 4; ++j) { s0 += (a[j].x * a[j].x + a[j].y * a[j].y) + (a[j].z * a[j].z + a[j].w * a[j].w); s1 += (b[j].x * b[j].x + b[j].y * b[j].y) + (b[j].z * b[j].z + b[j].w * b[j].w);
                        u32x2 w; w.x = pk2(a[j].x, a[j].y); w.y = pk2(a[j].z, a[j].w); o0[64 * j] = w; w.x = pk2(b[j].x, b[j].y); w.y = pk2(b[j].z, b[j].w); o1[64 * j] = w; }
                    s0 = wave_sum(s0); s1 = wave_sum(s1);
                    if (lane < 16) { slots[(size_t)m * 16 + lane] = lane == 0 ? s0 : 0.f; slots[(size_t)m2 * 16 + lane] = lane == 0 ? s1 : 0.f; } }
                for (int m = gw; m < MM; m += NGW) { const float ss = row_to_bf16(PIN(1) + (size_t)m * D, WSP(bf16_t, WS_MEMB) + (size_t)m * D, lane); if (lane == 0) rsm[m] = rsqrtf(ss * (1.f / 1024.f) + 1e-6f); }
                for (int idx = bx * 512 + tid; idx < 2048 * 64; idx += G * 512) { const int pos = idx >> 6, i = idx & 63;
                    const float theta = 1.f / powf(10000.f, (float)i / 63.f), ph = (float)pos * theta;
                    const float k = rintf(ph * 0.15915494309189535f); float r = fmaf(-k, 6.28125f, ph); r = fmaf(-k, 1.9353071795864769e-3f, r);
                    tab[2 * idx] = __cosf(r); tab[2 * idx + 1] = __sinf(r); }
            }
        LAS float* scr = (LAS float*)(L + wave * 16896);
        conv_set(ka, ws, 0, 0, gw, NGW, scr, lane); conv_set(ka, ws, 0, 1, gw, NGW, scr, lane);
        }
    if (gridDim.x == 0x7fffffffu) grid.sync();
    xcd_barrier(xbar, tid_of(wave_s));
    { volatile LAS unsigned* MISC = (volatile LAS unsigned*)(L + MISC_OFF); const int t0 = tid_of(wave_s);
      if (t0 == 0) { unsigned ok = gridDim.x == 256u ? 1u : 0u;
#pragma unroll
          for (unsigned j = 0; j < 8; ++j) ok &= (xb_ld(&xbar.bar[XL_RANK(j)]) == 32u) ? 1u : 0u;
          MISC[3] = ok; }
      __syncthreads();
      lok = (unsigned)__builtin_amdgcn_readfirstlane((int)MISC[3]);
      if (lok) bxv = (int)xbar.x + 8 * __builtin_amdgcn_readfirstlane((int)MISC[2]); }
#pragma unroll 1
    for (int l = 0; l < DEPTH; ++l) {
#ifndef SKIP_G1
        for (int dup_ = 0; dup_ < DUP_G1; ++dup_) { PH_BEGIN SchedStd Sd{(const char*)WSP(bf16_t, WS_XB), (const char*)WSP(char, WS_WIN), 64, 44, 1024, G, bx, (size_t)8 * 512 * 1024, 1};
          Unit u0; int pm0 = -1; if (Sd.next(0, u0)) pm0 = u0.pm & ~4; LAS float* rsl = (LAS float*)(L + 131072);
          if (pm0 >= 0) rsl[tid] = slot_rstd(WSP(float, WS_SLOT), (pm0 + 4 * (tid >> 8)) * 256 + (tid & 255));
          __syncthreads();
          EpiWin E{WSP(bf16_t, WS_U), WSP(bf16_t, WS_QKVC), WSP(float, WS_SLOT), WSP(float, WS_TAB), rsl, pm0};
          pg8::gemm_phase<EpiWin, SchedStd, true, true>(L, tid, pg8::Gemm{1024}, Sd, E); }
#endif
        GSYNC();
#ifndef SKIP_RS
        for (int dup_ = 0; dup_ < DUP_2A; ++dup_) { PH_BEGIN
          const int slot = bx >> 3, rs_u = lok ? (slot < 16 ? (bx & 7) * 16 + slot : -1) : (bx < 128 ? bx : -1), cv_i = lok ? (slot >= 16 ? (bx & 7) * 16 + slot - 16 : -1) : (bx >= 128 ? bx - 128 : -1);
          if (rs_u >= 0) ret_state_unit(WSP(bf16_t, WS_U), WSP(bf16_t, WS_RETST), rs_u, L, tid, lane, wave);
          if (l + 1 < DEPTH && cv_i >= 0) conv_set(ka, ws, l + 1, 0, cv_i * 8 + wave, 1024, (LAS float*)(L + wave * 16896), lane);
          __syncthreads(); }
#endif
        LSYNC();
#ifndef SKIP_L2
        for (int dup_ = 0; dup_ < DUP_LRU; ++dup_) { PH_BEGIN
#pragma unroll 1
          for (int u = vc; u < 256; u += G) lru_seq_unit(ka, l, WSP(bf16_t, WS_U), WSP(bf16_t, WS_BR) + (size_t)2 * M * D, WSP(bf16_t, WS_LRUW), u, L, tid, lane, wave); }
#endif
        __syncthreads();
#ifndef SKIP_RO
        for (int dup_ = 0; dup_ < DUP_2B; ++dup_) { PH_BEGIN
#pragma unroll 1
          for (int u = 2 * vc; u < 2 * vc + 2; ++u) ret_out_unit(WSP(bf16_t, WS_U), WSP(bf16_t, WS_RETST), WSP(bf16_t, WS_BR) + (size_t)M * D, u, L, tid, lane, wave); }
#endif
        __syncthreads();
#ifndef SKIP_AT
        for (int dup_ = 0; dup_ < DUP_AT; ++dup_) {
#pragma unroll 1
            for (int it = 0;; ++it) {
                { KA_GET(ka) int G = gridDim.x, bx = bxv; GAS1 unsigned char* ws = PWS; asm volatile("" : "+s"(G), "+s"(bx), "+s"(ws));
                  const int vc = lok ? (bx & 7) * 32 + (bx >> 3) : bx, pr = vc + (it >> 3) * G; if (pr >= 256) break;
                  const int bh = pr >> 2, s4 = pr & 3, b = bh >> 3, h = bh & 7, qb = (it & 4) ? s4 : 7 - s4, j = it & 3, c = j >> 1, vh = j & 1; const bf16_t* Qc = WSP(bf16_t, WS_QKVC);
                  const size_t pl = (size_t)2048 * 64, sel = (size_t)M * 1024;
                  attn_body::attn_unit<8>(0, 0, qb, (const attn_body::bf16*)(Qc + (size_t)(bh * 2 + c) * pl), (const attn_body::bf16*)(Qc + sel + (size_t)(bh * 2 + c) * pl),
                                          (const attn_body::bf16*)(Qc + 2 * sel + (size_t)(bh * 2 + vh) * pl), (attn_body::bf16*)(WSP(bf16_t, WS_OD4) + (size_t)b * S * 2048 + h * 256 + j * 64), (char*)lds, tid_of(wave_s)); }
                if ((it & 3) == 3) {
                    asm volatile("s_waitcnt vmcnt(0)" ::: "memory");
                    KA_GET(ka) int it2 = it, G = gridDim.x, bx = bxv, t2 = tid_of(wave_s); GAS1 unsigned char* ws = PWS; asm volatile("" : "+s"(it2), "+s"(G), "+s"(bx), "+s"(ws));
                    const int vc = lok ? (bx & 7) * 32 + (bx >> 3) : bx, pr = vc + (it2 >> 3) * G, bh = pr >> 2, s4 = pr & 3, b = bh >> 3, h = bh & 7, qb = (it2 & 4) ? s4 : 7 - s4;
                    const int ln = t2 & 63, wv = t2 >> 6;
                    const float lam_init = 0.8f - 0.6f * (l == 0 ? 1.f : l == 1 ? 0.7408182206817179f : l == 2 ? 0.5488116360940264f : 0.4065696597405991f);
                    float lam;
                    { const float a = PIN(4)[l * 64 + ln] * PIN(5)[l * 64 + ln], c = PIN(6)[l * 64 + ln] * PIN(7)[l * 64 + ln]; lam = __expf(wave_sum(a)) - __expf(wave_sum(c)) + lam_init; }
                    const float g0 = PIN(8)[l * 128 + 2 * ln] * (1.f - lam_init), g1 = PIN(8)[l * 128 + 2 * ln + 1] * (1.f - lam_init);
                    const size_t row0 = (size_t)b * S + qb * 256 + wv * 32; const int vh = ln >> 5, cw = ln & 31;
                    bf16_t* OD4 = WSP(bf16_t, WS_OD4); bf16_t* BR = WSP(bf16_t, WS_BR);
#pragma unroll 1
                    for (int r0 = 0; r0 < 32; r0 += 16) {
                        unsigned av[16], cv[16];
#pragma unroll
                        for (int rr = 0; rr < 16; ++rr) { unsigned* o4 = (unsigned*)(OD4 + (row0 + r0 + rr) * 2048 + h * 256);
                            av[rr] = __hip_atomic_load(o4 + vh * 32 + cw, __ATOMIC_RELAXED, __HIP_MEMORY_SCOPE_AGENT); cv[rr] = __hip_atomic_load(o4 + (2 + vh) * 32 + cw, __ATOMIC_RELAXED, __HIP_MEMORY_SCOPE_AGENT); }
#pragma unroll
                        for (int rr = 0; rr < 16; ++rr) { const float d0 = bflo(av[rr]) - lam * bflo(cv[rr]), d1 = bfhi(av[rr]) - lam * bfhi(cv[rr]); const float rstd = rsqrtf(wave_sum(d0 * d0 + d1 * d1) * (1.f / 128.f) + 1e-5f);
                            *(unsigned*)(BR + (row0 + r0 + rr) * D + h * 128 + 2 * ln) = pk2(d0 * rstd * g0, d1 * rstd * g1); } }
                }
            }
        }
#endif
        LSYNC();
#ifndef SKIP_G3
        for (int dup_ = 0; dup_ < DUP_G3; ++dup_) { PH_BEGIN SchedBranch Sd{(const char*)WSP(bf16_t, WS_BR), (const char*)WSP(char, WS_WBR), G, bx}; EpiBranch E{WSP(bf16_t, WS_U), WSP(bf16_t, WS_MERGED)};
          pg8::gemm_phase<EpiBranch, SchedBranch, true, true>(L, tid, pg8::Gemm{1024}, Sd, E); }
#endif
        LSYNC();
#ifndef SKIP_G4
        for (int dup_ = 0; dup_ < (l == 0 ? DUP_G4 : 1); ++dup_) { PH_BEGIN SchedStd Sd{(const char*)WSP(bf16_t, WS_MERGED), (const char*)WSP(char, WS_WOUT), 64, 4, 1024, G, bx, MBS * 2}; EpiResid E{l == 0 ? PIN(0) : POUT, POUT, WSP(bf16_t, WS_XB), WSP(float, WS_SLOT)};
          pg8::gemm_phase<EpiResid, SchedStd, true, true>(L, tid, pg8::Gemm{1024}, Sd, E); }
#endif
        LSYNC();
#ifndef SKIP_G5
        for (int dup_ = 0; dup_ < DUP_G5; ++dup_) { PH_BEGIN SchedXA Sd{(const char*)WSP(bf16_t, WS_XB), (const char*)WSP(bf16_t, WS_MEMB), (const char*)WSP(char, WS_WQ), (const char*)WSP(char, WS_WKV), G, bx};
          LAS float* rsl = (LAS float*)(L + 131072); { Unit u0; if (Sd.next(0, u0) && u0.aux == 0 && tid < 256) rsl[tid] = slot_rstd(WSP(float, WS_SLOT), u0.pm * 256 + tid); }
          __syncthreads();
          EpiXA E{WSP(bf16_t, WS_QX), WSP(bf16_t, WS_KX), WSP(bf16_t, WS_VXT), WSP(float, WS_SLOT), WSP(float, WS_RSM), rsl};
          pg8::gemm_phase<EpiXA, SchedXA, true, true>(L, tid, pg8::Gemm{1024}, Sd, E);
          if (bx >= 160) conv_set(ka, ws, l, 2, (bx - 160) * 8 + wave, (G - 160) * 8, (LAS float*)(L + wave * 16896), lane); }
#endif
        GSYNC();
#ifndef SKIP_XA
        for (int dup_ = 0; dup_ < DUP_XA; ++dup_) { PH_BEGIN
#pragma unroll 1
          for (int u = vc; u < 256; u += G) xattn_unit(WSP(bf16_t, WS_QX), WSP(bf16_t, WS_KX), WSP(bf16_t, WS_VXT), WSP(bf16_t, WS_OX), u, L, tid, lane, wave);
          __syncthreads();
          if (l + 1 < DEPTH) conv_set(ka, ws, l + 1, 1, bx * 8 + wave, G * 8, (LAS float*)(L + wave * 16896), lane); }
#endif
        LSYNC();
#ifndef SKIP_G7
        { PH_BEGIN SchedStd Sd{(const char*)WSP(bf16_t, WS_OX), (const char*)WSP(char, WS_WO), 64, 4, 512, G, bx, (size_t)8 * 512 * 512}; EpiResid E{POUT, POUT, WSP(bf16_t, WS_XB), WSP(float, WS_SLOT)};
          pg8::gemm_phase<EpiResid, SchedStd, true, true>(L, tid, pg8::Gemm{512}, Sd, E); }
#endif
        LSYNC();
#ifndef SKIP_G8
        for (int dup_ = 0; dup_ < DUP_G8; ++dup_) { PH_BEGIN SchedStd Sd{(const char*)WSP(bf16_t, WS_XB), (const char*)WSP(char, WS_W1), 64, 16, 1024, G, bx, (size_t)8 * 512 * 1024, 1};
          Unit u0; int pm0 = -1; if (Sd.next(0, u0)) pm0 = u0.pm & ~4; LAS float* rsl = (LAS float*)(L + 131072);
          if (pm0 >= 0) rsl[tid] = slot_rstd(WSP(float, WS_SLOT), (pm0 + 4 * (tid >> 8)) * 256 + (tid & 255));
          __syncthreads();
          EpiW1 E{WSP(bf16_t, WS_H), WSP(float, WS_SLOT), rsl, pm0};
          pg8::gemm_phase<EpiW1, SchedStd, true, true>(L, tid, pg8::Gemm{1024}, Sd, E); }
#endif
        LSYNC();
#ifndef SKIP_G9
        for (int dup_ = 0; dup_ < DUP_G9; ++dup_) { PH_BEGIN SchedStd Sd{(const char*)WSP(bf16_t, WS_H), (const char*)WSP(char, WS_W2), 64, 4, 4096, G, bx, UBS * 2}; EpiResid E{POUT, dup_ + 1 < DUP_G9 ? WSP(float, WS_QX) : POUT, WSP(bf16_t, WS_XB), WSP(float, WS_SLOT)};
          pg8::gemm_phase<EpiResid, SchedStd, true, true>(L, tid, pg8::Gemm{4096}, Sd, E); }
#endif
        LSYNC();
    }
    { PH_BEGIN const float* slots = WSP(float, WS_SLOT); float* out = POUT;
      const int m0 = lok ? (bx & 7) * 2048 + (bx >> 3) * 8 + wave : bx * 8 + wave, mstep = lok ? 256 : G * 8, mend = lok ? ((bx & 7) + 1) * 2048 : M;
      const f32x4* gr = (const f32x4*)PIN(26) + lane; f32x4 gv[4];
#pragma unroll
      for (int j = 0; j < 4; ++j) gv[j] = gr[64 * j];
      for (int m = m0; m < mend; m += 2 * mstep) { const int m2 = m + mstep;
        const float rs0 = slot_rstd(slots, m), rs1 = slot_rstd(slots, m2); f32x4* x0 = (f32x4*)(out + (size_t)m * D) + lane; f32x4* x1 = (f32x4*)(out + (size_t)m2 * D) + lane; f32x4 a[4], b[4];
#pragma unroll
        for (int j = 0; j < 4; ++j) { a[j] = x0[64 * j]; b[j] = x1[64 * j]; }
#pragma unroll
        for (int j = 0; j < 4; ++j) { x0[64 * j] = a[j] * rs0 * gv[j]; x1[64 * j] = b[j] * rs1 * gv[j]; } } }
}

extern "C" void kernel_launch(void* const* d_in, const int* in_sizes, int n_in, void* d_out, int out_size, void* d_ws, size_t ws_size, hipStream_t stream) {
    static int grid = 0;
    if (grid == 0) {
        if (n_in != 27 || out_size != M * D || ws_size < WS_END) { fprintf(stderr, "kernel_launch: unexpected shapes (n_in %d, out %d, ws %zu)\n", n_in, out_size, ws_size); grid = -1; return; }
        int dev = 0, cus = 0, per_cu = 0;
        hipGetDevice(&dev); hipDeviceGetAttribute(&cus, hipDeviceAttributeMultiprocessorCount, dev);
        hipFuncSetAttribute((const void*)fwd_megakernel, hipFuncAttributeMaxDynamicSharedMemorySize, LDS_BYTES);
        hipOccupancyMaxActiveBlocksPerMultiprocessor(&per_cu, (const void*)fwd_megakernel, 512, LDS_BYTES);
        if (per_cu < 1) per_cu = 1;
        (void)hipGetLastError();
        grid = cus * per_cu; if (grid > 256) grid = 256;
        if (grid != 256) { fprintf(stderr, "kernel_launch: needs a 256-workgroup cooperative grid, got %d\n", grid); grid = -1; return; }
    }
    if (grid < 0) return;
    Params p{};
    for (int i = 0; i < 27; ++i) p.in[i] = (const float*)d_in[i];
    p.out = (float*)d_out; p.ws = (unsigned char*)d_ws;
    if (hipMemsetAsync(d_ws, 0, 65536, stream) != hipSuccess) { fprintf(stderr, "memset failed\n"); return; }
    void* args[] = {&p};
    hipError_t e = hipLaunchCooperativeKernel((void*)fwd_megakernel, dim3(grid), dim3(512), args, LDS_BYTES, stream);
    if (e != hipSuccess) fprintf(stderr, "cooperative launch failed: %s (grid %d)\n", hipGetErrorString(e), grid);
}
```

```cpp
#include <hip/hip_runtime.h>
#include <hip/hip_cooperative_groups.h>
#include <cstdio>
#include <cstdint>
namespace cg = cooperative_groups;

namespace pg8 {
#define PG8_LAS __attribute__((address_space(3)))
typedef unsigned short bf16_t;
typedef short bf16x8 __attribute__((ext_vector_type(8)));
typedef float f32x4 __attribute__((ext_vector_type(4)));
typedef unsigned u32x4 __attribute__((ext_vector_type(4)));
constexpr int BM = 256, BK = 64, HALF = 128, HTB = HALF * BK * 2  , STAGE_BYTES = 8 * HTB, NXCD = 8, WGM = 8;

__host__ __device__ __forceinline__ int lds_byte(int r, int c) { const int st = (r >> 4) * 2 + (c >> 5), rr = r & 15, cc = c & 31, ob = rr * 64 + cc * 2; return st * 1024 + (ob ^ (((ob >> 9) & 1) << 5)); }
__host__ __device__ __forceinline__ void stage_rc(int b, int& R, int& C) { const int st = b / 1024, sb = b % 1024, swz = sb ^ (((sb >> 9) & 1) << 5); R = (st >> 1) * 16 + swz / 64; C = (st & 1) * 32 + (swz % 64) / 2; }
__host__ __device__ __forceinline__ int perm32(int rho) { const int n = rho >> 4, i = rho & 15; return 8 * (i >> 2) + 4 * n + (i & 3); }

struct Unit { const char* a; const char* b; int pm, pn, aux; };
struct Gemm { int K; };

__device__ __forceinline__ unsigned cvt_pk_bf16(float lo, float hi) { unsigned r; asm volatile("v_cvt_pk_bf16_f32 %0, %1, %2" : "=v"(r) : "v"(lo), "v"(hi)); return r; }
typedef float f32x2 __attribute__((ext_vector_type(2)));
template <class Epi, class Sched, bool ALIGN_EPI = false, bool SP2 = false>
__device__ __forceinline__ void gemm_phase(PG8_LAS unsigned char* lds, const int tid_in, const Gemm g, const Sched& S, const Epi& E) {
    const int tid = tid_in, wid = __builtin_amdgcn_readfirstlane(tid >> 6), lane = tid & 63, wr = wid >> 2, wc = wid & 3, fr = lane & 15, fq = lane >> 4;
    const int K = g.K, nt = K / BK;
    unsigned voffA[2], voffB[2];
#pragma unroll
    for (int i = 0; i < 2; ++i) { int R, C; stage_rc(tid * 16 + i * 8192, R, C); const int Rb = Epi::PERM ? ((R & ~31) + perm32(R & 31)) : R;
        voffA[i] = (unsigned)(R * K + C) * 2u; voffB[i] = (unsigned)(Rb * K + C) * 2u; }
    const size_t kstep = (size_t)(BK * 2);
    const size_t hstep = (size_t)HALF * K * 2;
    const unsigned ldsw = (unsigned)wid * 1024u;
    const int aoff = lds_byte(wr * 64 + fr, fq * 8), boff = lds_byte(wc * 32 + fr, fq * 8);
#define PG8_SA(b, h) (((b) * 2 + (h)) * HTB)
#define PG8_SB(b, h) ((4 + (b) * 2 + (h)) * HTB)
#define PG8_STAGE(bufoff, gbase, voff) do { _Pragma("unroll") for (int _i = 0; _i < 2; ++_i) \
        __builtin_amdgcn_global_load_lds((const unsigned*)((const char*)(gbase) + (voff)[_i]), (PG8_LAS unsigned*)(lds + (bufoff) + ldsw + _i * 8192), 16, 0, 0); } while (0)
#define PG8_LDA(dst, b, h) do { _Pragma("unroll") for (int m = 0; m < 4; ++m) _Pragma("unroll") for (int k = 0; k < 2; ++k) dst[m][k] = *(const PG8_LAS bf16x8*)(lds + PG8_SA(b, h) + aoff + m * 2048 + k * 1024); } while (0)
#define PG8_LDB(dst, b, h) do { _Pragma("unroll") for (int n = 0; n < 2; ++n) _Pragma("unroll") for (int k = 0; k < 2; ++k) dst[n][k] = *(const PG8_LAS bf16x8*)(lds + PG8_SB(b, h) + boff + n * 2048 + k * 1024); } while (0)
#define PG8_MMA(ai, bj, At, Bt) do { __builtin_amdgcn_s_setprio(1); _Pragma("unroll") for (int m = 0; m < 4; ++m) _Pragma("unroll") for (int n = 0; n < 2; ++n) _Pragma("unroll") for (int k = 0; k < 2; ++k) \
        acc[ai][bj][m][n] = __builtin_amdgcn_mfma_f32_16x16x32_bf16(Bt[n][k], At[m][k], acc[ai][bj][m][n], 0, 0, 0); __builtin_amdgcn_s_setprio(0); } while (0)
#define PG8_WAIT_V(n) asm volatile("s_waitcnt vmcnt(" #n ")" ::: "memory")
#define PG8_WAIT_L(n) asm volatile("s_waitcnt lgkmcnt(" #n ")" ::: "memory")
#define PG8_BAR __builtin_amdgcn_s_barrier()
#define PG8_SCHED __builtin_amdgcn_sched_barrier(0)
    Unit cur, nxt; int ui = 0;
    if (!S.next(0, cur)) return;
    f32x4 acc[2][2][4][2];
#pragma unroll
    for (int a = 0; a < 2; ++a)
#pragma unroll
        for (int b = 0; b < 2; ++b)
#pragma unroll
            for (int m = 0; m < 4; ++m)
#pragma unroll
                for (int n = 0; n < 2; ++n) acc[a][b][m][n] = (f32x4){0.f, 0.f, 0.f, 0.f};
    bf16x8 At[4][2], B0[2][2], B1[2][2];
    const char* cA = cur.a; const char* cB = cur.b;
    if constexpr (SP2) {
        PG8_STAGE(PG8_SB(0, 0), cB, voffB); PG8_STAGE(PG8_SB(0, 1), cB + hstep, voffB); PG8_STAGE(PG8_SA(0, 0), cA, voffA); PG8_STAGE(PG8_SA(0, 1), cA + hstep, voffA);
        if (wr == 1) PG8_BAR;
        PG8_WAIT_V(2); PG8_BAR;
        PG8_STAGE(PG8_SB(1, 0), cB + kstep, voffB); PG8_STAGE(PG8_SA(1, 0), cA + kstep, voffA); PG8_STAGE(PG8_SB(1, 1), cB + hstep + kstep, voffB);
        PG8_WAIT_V(6); PG8_BAR;
    } else {
        PG8_STAGE(PG8_SB(0, 0), cB, voffB); PG8_STAGE(PG8_SA(0, 0), cA, voffA); PG8_STAGE(PG8_SB(0, 1), cB + hstep, voffB); PG8_STAGE(PG8_SA(0, 1), cA + hstep, voffA);
        if (wr == 1) PG8_BAR;
        PG8_WAIT_V(4); PG8_BAR;
        PG8_STAGE(PG8_SB(1, 0), cB + kstep, voffB); PG8_STAGE(PG8_SA(1, 0), cA + kstep, voffA); PG8_STAGE(PG8_SB(1, 1), cB + hstep + kstep, voffB);
        PG8_WAIT_V(6); PG8_BAR;
    }
    for (;;) {
        const bool has_next = S.next(ui + 1, nxt);
        const char* nA = has_next ? nxt.a : cA; const char* nB = has_next ? nxt.b : cB;
        for (int t = 0; t < nt; t += 2) {
            const bool last = (t == nt - 2);
            const char* a1 = cA + (size_t)(t + 1) * kstep;
            const char* a2 = last ? nA : cA + (size_t)(t + 2) * kstep; const char* b2 = last ? nB : cB + (size_t)(t + 2) * kstep;
            const char* a3 = a2 + kstep; const char* b3 = b2 + kstep;
            if constexpr (SP2) {
            PG8_LDB(B0, 0, 0); PG8_LDB(B1, 0, 1); PG8_SCHED; PG8_LDA(At, 0, 0); PG8_STAGE(PG8_SA(1, 1), a1 + hstep, voffA);
            PG8_WAIT_V(8); PG8_WAIT_L(0); PG8_BAR; PG8_MMA(0, 0, At, B0); PG8_MMA(0, 1, At, B1); PG8_BAR; PG8_SCHED;
            PG8_LDA(At, 0, 1); PG8_STAGE(PG8_SB(0, 0), b2, voffB); PG8_STAGE(PG8_SB(0, 1), b2 + hstep, voffB); PG8_STAGE(PG8_SA(0, 0), a2, voffA);
            PG8_WAIT_V(8); PG8_WAIT_L(0); PG8_BAR; PG8_MMA(1, 0, At, B0); PG8_MMA(1, 1, At, B1); PG8_BAR; PG8_SCHED;
            PG8_LDB(B0, 1, 0); PG8_LDB(B1, 1, 1); PG8_SCHED; PG8_LDA(At, 1, 0); PG8_STAGE(PG8_SA(0, 1), a2 + hstep, voffA);
            PG8_WAIT_V(8); PG8_WAIT_L(0); PG8_BAR; PG8_MMA(0, 0, At, B0); PG8_MMA(0, 1, At, B1); PG8_BAR; PG8_SCHED;
            PG8_LDA(At, 1, 1); PG8_STAGE(PG8_SB(1, 0), b3, voffB); PG8_STAGE(PG8_SB(1, 1), b3 + hstep, voffB); PG8_STAGE(PG8_SA(1, 0), a3, voffA);
            PG8_WAIT_V(8); PG8_WAIT_L(0); PG8_BAR; PG8_MMA(1, 0, At, B0); PG8_MMA(1, 1, At, B1); PG8_BAR; PG8_SCHED;
            } else {
            PG8_LDB(B0, 0, 0); PG8_SCHED; PG8_LDA(At, 0, 0); PG8_STAGE(PG8_SA(1, 1), a1 + hstep, voffA);
            PG8_WAIT_L(8); PG8_BAR; PG8_WAIT_L(0); PG8_MMA(0, 0, At, B0); PG8_BAR; PG8_SCHED;
            PG8_LDB(B1, 0, 1); PG8_STAGE(PG8_SB(0, 0), b2, voffB);
            PG8_BAR; PG8_WAIT_L(0); PG8_MMA(0, 1, At, B1); PG8_BAR;
            PG8_LDA(At, 0, 1); PG8_STAGE(PG8_SA(0, 0), a2, voffA);
            PG8_BAR; PG8_WAIT_L(0); PG8_MMA(1, 0, At, B0); PG8_BAR; PG8_SCHED;
            PG8_STAGE(PG8_SB(0, 1), b2 + hstep, voffB);
            PG8_WAIT_V(6); PG8_BAR; PG8_MMA(1, 1, At, B1); PG8_BAR;
            PG8_LDB(B0, 1, 0); PG8_SCHED; PG8_LDA(At, 1, 0); PG8_STAGE(PG8_SA(0, 1), a2 + hstep, voffA);
            PG8_WAIT_L(8); PG8_BAR; PG8_WAIT_L(0); PG8_MMA(0, 0, At, B0); PG8_BAR; PG8_SCHED;
            PG8_LDB(B1, 1, 1); PG8_STAGE(PG8_SB(1, 0), b3, voffB);
            PG8_BAR; PG8_WAIT_L(0); PG8_MMA(0, 1, At, B1); PG8_BAR;
            PG8_LDA(At, 1, 1); PG8_STAGE(PG8_SA(1, 0), a3, voffA);
            PG8_BAR; PG8_WAIT_L(0); PG8_MMA(1, 0, At, B0); PG8_BAR; PG8_SCHED;
            PG8_STAGE(PG8_SB(1, 1), b3 + hstep, voffB);
            PG8_WAIT_V(6); PG8_BAR; PG8_MMA(1, 1, At, B1); PG8_BAR;
            }
        }
        if constexpr (ALIGN_EPI) { if (wr == 0) PG8_BAR; }
        E(acc, cur, wr, wc, fr, fq);
        if (!has_next) break;
        if (!E.keep(cur))
#pragma unroll
        for (int a = 0; a < 2; ++a)
#pragma unroll
            for (int b = 0; b < 2; ++b)
#pragma unroll
                for (int m = 0; m < 4; ++m)
#pragma unroll
                    for (int n = 0; n < 2; ++n) acc[a][b][m][n] = (f32x4){0.f, 0.f, 0.f, 0.f};
        cur = nxt; cA = nA; cB = nB; ++ui;
        if constexpr (ALIGN_EPI) { if (wr == 1) PG8_BAR; }
    }
    PG8_WAIT_V(0);
    if constexpr (!ALIGN_EPI) { if (wr == 0) PG8_BAR; }
    PG8_BAR;
#undef PG8_SA
#undef PG8_SB
#undef PG8_STAGE
#undef PG8_LDA
#undef PG8_LDB
#undef PG8_MMA
#undef PG8_WAIT_V
#undef PG8_WAIT_L
#undef PG8_BAR
#undef PG8_SCHED
}
}
#include <hip/hip_bf16.h>
#include <cmath>
namespace attn_body {
using bf16=__hip_bfloat16;
using bf16x8=__attribute__((ext_vector_type(8)))short;
using s16x4=__attribute__((ext_vector_type(4)))short;
using f32x16=__attribute__((ext_vector_type(16)))float;
using u32x4=__attribute__((ext_vector_type(4)))unsigned;
constexpr int BATCH=8,NHEAD=8,SEQ=2048,D=64,DM=64,OP=2048;
constexpr int NW=8,QBLK=32,QB=QBLK*NW,KVBLK=64,NQB=SEQ/QB;
constexpr int ATTN_PITCH=DM, ATTN_UNIT_ROWS=QB;
__device__ __forceinline__ int crow(int r,int hi){return (r&3)+8*(r>>2)+4*hi;}
#define SBAR() __builtin_amdgcn_sched_barrier(0)
__device__ __forceinline__ void cmask(f32x16&p0,f32x16&p1,int jb,int qrel,int hi){
  const float NEG=-INFINITY; int kb=64*jb+4*hi;
  #pragma unroll
  for(int r=0;r<16;++r){int kv=kb+(r&3)+8*(r>>2); if(kv>qrel)p0[r]=NEG; if(kv+32>qrel)p1[r]=NEG;}
}

constexpr int NSLOT=3, SLOTB=8192;
constexpr int LDS_K=0, LDS_V=NSLOT*SLOTB, LDS_WS=2*NSLOT*SLOTB, LDS_OST=LDS_WS+NW*64*4, LDS_BYTES=LDS_OST+NW*4096;
constexpr float C2=0.125f*1.4426950408889634f;
__device__ __forceinline__ void glds16(const void*gsrc,unsigned lds_dst){unsigned keep;
  asm volatile("s_mov_b32 %0, m0\n\ts_mov_b32 m0, %2\n\ts_nop 0\n\tglobal_load_lds_dwordx4 %1, off\n\ts_mov_b32 m0, %0":"=&s"(keep):"v"(gsrc),"s"(lds_dst):"memory");}
__device__ __forceinline__ float max3f(float a,float b,float c){float r;asm("v_max3_f32 %0, %1, %2, %3":"=v"(r):"v"(a),"v"(b),"v"(c));return r;}
__device__ __forceinline__ float max2f(float a,float b){float r;asm("v_max_f32_e32 %0, %1, %2":"=v"(r):"v"(a),"v"(b));return r;}
__device__ __forceinline__ float fadd_s(float a,float b){float r;asm("v_add_f32_e32 %0, %1, %2":"=v"(r):"v"(a),"v"(b));return r;}
__device__ __forceinline__ float fsub_s(float a,float b){float r;asm("v_sub_f32_e32 %0, %1, %2":"=v"(r):"v"(a),"v"(b));return r;}
typedef float f32x2_t __attribute__((ext_vector_type(2))); typedef __bf16 bf16x2_t __attribute__((ext_vector_type(2)));
__device__ __forceinline__ unsigned cvtpk_s(float lo,float hi){f32x2_t v={lo,hi};bf16x2_t b=__builtin_convertvector(v,bf16x2_t);return __builtin_bit_cast(unsigned,b);}
#define WAIT_BAR(N) asm volatile("s_waitcnt vmcnt(" #N ") lgkmcnt(0)\n\ts_barrier":::"memory")

__device__ __forceinline__ void qkt(f32x16&p0,f32x16&p1,const char*Kslot,const bf16x8*qr,const f32x16&negm,int r32,int hi){
  const char*kb=Kslot+hi*1024+r32*16;
  #pragma unroll
  for(int d0=0;d0<4;++d0){
    const bf16x8 b0=*reinterpret_cast<const bf16x8*>(kb+d0*2048);
    const bf16x8 b1=*reinterpret_cast<const bf16x8*>(kb+d0*2048+512);
    if(d0==0){p0=__builtin_amdgcn_mfma_f32_32x32x16_bf16(b0,qr[0],negm,0,0,0);p1=__builtin_amdgcn_mfma_f32_32x32x16_bf16(b1,qr[0],negm,0,0,0);}
    else{p0=__builtin_amdgcn_mfma_f32_32x32x16_bf16(b0,qr[d0],p0,0,0,0);p1=__builtin_amdgcn_mfma_f32_32x32x16_bf16(b1,qr[d0],p1,0,0,0);}}
}
typedef __attribute__((address_space(3))) const char* lds_cptr;
typedef short v4i16_t __attribute__((ext_vector_type(4)));
__device__ __forceinline__ void kload8(bf16x8*kf,lds_cptr kp){
  kf[0]=*(const __attribute__((address_space(3))) bf16x8*)(kp);      kf[1]=*(const __attribute__((address_space(3))) bf16x8*)(kp+512);
  kf[2]=*(const __attribute__((address_space(3))) bf16x8*)(kp+2048); kf[3]=*(const __attribute__((address_space(3))) bf16x8*)(kp+2560);
  kf[4]=*(const __attribute__((address_space(3))) bf16x8*)(kp+4096); kf[5]=*(const __attribute__((address_space(3))) bf16x8*)(kp+4608);
  kf[6]=*(const __attribute__((address_space(3))) bf16x8*)(kp+6144); kf[7]=*(const __attribute__((address_space(3))) bf16x8*)(kp+6656);
}
__device__ __forceinline__ void kload2(bf16x8*kf,lds_cptr kp,int j){ kf[2*j]=*(const __attribute__((address_space(3))) bf16x8*)(kp+j*2048); kf[2*j+1]=*(const __attribute__((address_space(3))) bf16x8*)(kp+j*2048+512); }
__device__ __forceinline__ s16x4 vtr(lds_cptr p){ return __builtin_bit_cast(s16x4,__builtin_amdgcn_ds_read_tr16_b64_v4i16((__attribute__((address_space(3))) v4i16_t*)p)); }
__device__ __forceinline__ float rowmax(const f32x16&p0,const f32x16&p1){
  float a=max3f(p0[0],p0[1],p1[0]),b=max3f(p0[2],p0[3],p1[1]);a=max3f(a,p1[2],p1[3]);
  #pragma unroll
  for(int r=4;r<16;r+=4){a=max3f(a,p0[r],p0[r+1]);b=max3f(b,p0[r+2],p0[r+3]);a=max3f(a,p1[r],p1[r+1]);b=max3f(b,p1[r+2],p1[r+3]);}
  const float m=max2f(a,b);
  auto rr=__builtin_amdgcn_permlane32_swap(__float_as_uint(m),__float_as_uint(m),false,false);
  return max2f(__uint_as_float(rr[0]),__uint_as_float(rr[1]));
}
__device__ __forceinline__ void pv(f32x16*o,int vb,bf16x8 pa0,bf16x8 pa1,bf16x8 pa2,bf16x8 pa3){
  #pragma unroll
  for(int d0=0;d0<2;++d0){s16x4 lo[4],hi[4];
    #pragma unroll
    for(int ks=0;ks<4;++ks){
      asm volatile("ds_read_b64_tr_b16 %0,%1 offset:%c2":"=&v"(lo[ks]):"v"(vb),"i"(d0*4096+ks*1024):"memory");
      asm volatile("ds_read_b64_tr_b16 %0,%1 offset:%c2":"=&v"(hi[ks]):"v"(vb),"i"(d0*4096+ks*1024+512):"memory");}
    asm volatile("s_waitcnt lgkmcnt(0)":::"memory");SBAR();
    #define PK(k) (bf16x8){lo[k][0],lo[k][1],lo[k][2],lo[k][3],hi[k][0],hi[k][1],hi[k][2],hi[k][3]}
    o[d0]=__builtin_amdgcn_mfma_f32_32x32x16_bf16(pa0,PK(0),o[d0],0,0,0);
    o[d0]=__builtin_amdgcn_mfma_f32_32x32x16_bf16(pa1,PK(1),o[d0],0,0,0);
    o[d0]=__builtin_amdgcn_mfma_f32_32x32x16_bf16(pa2,PK(2),o[d0],0,0,0);
    o[d0]=__builtin_amdgcn_mfma_f32_32x32x16_bf16(pa3,PK(3),o[d0],0,0,0);
    #undef PK
  }
}

#ifndef ATTN_STORE16
#define ATTN_STORE16(p,v) (*(u32x4*)(p)=(v))
#endif
template<int THRL> __device__ __forceinline__ void attn_unit(int b,int h,int qb,const bf16*Q,const bf16*__restrict__ K,const bf16*__restrict__ V,bf16*O,char*shm,const int tid_in){
  const int tid=tid_in,lane=tid&63,r32=lane&31,hi=lane>>5; const int wid=__builtin_amdgcn_readfirstlane(tid>>6);
  const long rowbase=(long)b*SEQ; const int q0=qb*QB;
  const bf16*Qw=Q+(rowbase+q0+wid*QBLK)*DM+h*D;
  const bf16*Kh=K+rowbase*DM+h*D,*Vh=V+rowbase*DM+h*D;
  const unsigned lds0=(unsigned)(uintptr_t)shm;
  float*wsf=(float*)(shm+LDS_WS)+wid*64;
  const bf16*ksrc=Kh+(long)lane*DM+wid*8;
  const bf16*vsrc=Vh+(long)(16*(wid&3)+(lane>>2))*DM+(wid>>2)*32+(lane&3)*8;
  const unsigned kdst=lds0+LDS_K+wid*1024, vdst=lds0+LDS_V+wid*1024;
  #define DMA_K(t,slot) glds16(ksrc+(long)(t)*KVBLK*DM,(unsigned)__builtin_amdgcn_readfirstlane(kdst+(slot)))
  #define DMA_V(t,slot) glds16(vsrc+(long)(t)*KVBLK*DM,(unsigned)__builtin_amdgcn_readfirstlane(vdst+(slot)))
  const int vb0=(int)(lds0+LDS_V)+((lane>>4)&1)*32+(lane&3)*8+(4*hi+((lane&15)>>2))*64;
  const char*Kbase=shm+LDS_K; bf16x8 kf[8];
  const lds_cptr shm3=(lds_cptr)shm; const lds_cptr kp0=shm3+LDS_K+hi*1024+r32*16; const lds_cptr vp0=shm3+LDS_V+((lane>>4)&1)*32+(lane&3)*8+(4*hi+((lane&15)>>2))*64;
  const int NT=(q0+QB)/KVBLK;
  DMA_K(0,0);DMA_V(0,0);DMA_K(1,SLOTB);
  bf16x8 qr[4];
  #pragma unroll
  for(int d0=0;d0<4;++d0)qr[d0]=*reinterpret_cast<const bf16x8*>(&Qw[(long)r32*DM+d0*16+hi*8]);
  float mhat=0.f,l_reg=0.f;f32x16 o[2];o[0]=f32x16{};o[1]=f32x16{};f32x16 negm=f32x16{};asm volatile("":"+v"(negm));
  const int qrel=wid*QBLK+r32;
  #define CMASK(P0,P1,t) do{int jb_=(t)-(NT-4); if(jb_>=0)cmask(P0,P1,jb_,qrel,hi);}while(0)
  bool resc=false;
  #define START(P0,P1) do{ const float rm=rowmax(P0,P1); resc=false; \
    { const float dl=rm; mhat=fadd_s(mhat,dl); \
      _Pragma("unroll") for(int r=0;r<16;++r){P0[r]=fsub_s(P0[r],dl);P1[r]=fsub_s(P1[r],dl);} \
      _Pragma("unroll") for(int r=0;r<16;++r)negm[r]=-mhat; asm volatile("":"+v"(negm)); } \
    _Pragma("unroll") for(int r=0;r<16;++r)P0[r]=__builtin_amdgcn_exp2f(P0[r]); }while(0)
  #define RESC() do{ if(resc){ asm volatile("s_waitcnt lgkmcnt(0)":::"memory"); \
      _Pragma("unroll") for(int d_=0;d_<2;++d_) _Pragma("unroll") for(int r=0;r<16;++r)o[d_][r]*=wsf[crow(r,hi)]; } }while(0)
  f32x16 pA0,pA1,pB0,pB1;
  int sl_prev=0,sl_cur=0,sl_next=SLOTB;
  #define ROT() do{sl_prev=sl_cur;sl_cur=sl_next;sl_next=(sl_next==(NSLOT-1)*SLOTB)?0:sl_next+SLOTB;}while(0)
  DMA_K(2,2*SLOTB);
  WAIT_BAR(3);
  qkt(pA0,pA1,Kbase,qr,negm,r32,hi);asm volatile("s_nop 15\n\ts_nop 7":"+v"(pA0),"+v"(pA1));CMASK(pA0,pA1,0);
  START(pA0,pA1);
  _Pragma("unroll") for(int r=0;r<16;++r)pA1[r]=__builtin_amdgcn_exp2f(pA1[r]);
  WAIT_BAR(0);
  DMA_K(3,0);DMA_V(1,SLOTB);
  ROT();
  kload8(kf,kp0+sl_cur);
  WAIT_BAR(2);
  s16x4 vlo[8],vhi[8]; u32x4 pw0,pw1,pw2,pw3;
  #define PKW(P,B) cvtpk_s(P[B],P[B+1])
  #define PAF(k) __builtin_bit_cast(bf16x8,pw##k)
  #define VFR(i) (bf16x8){vlo[i][0],vlo[i][1],vlo[i][2],vlo[i][3],vhi[i][0],vhi[i][1],vhi[i][2],vhi[i][3]}
  #define PIN(x) asm volatile("":"+v"(x))
  #define MX3(a,b,c) __builtin_fmaxf(__builtin_fmaxf((a),(b)),(c))
  #define GAPA(MF,A0,A1,A2,A3,W0,W1,PW) do{ MF; sacc+=A0; sacc+=A1; sacc+=A2; sacc+=A3; PIN(sacc); W0; W1; PIN(PW); SBAR(); }while(0)
  #define EX(v) __builtin_amdgcn_exp2f(v)
  #define GAPB(MF,X,B) do{ MF; X[B]=EX(X[B]); X[B+1]=EX(X[B+1]); X[B+2]=EX(X[B+2]); X[B+3]=EX(X[B+3]); PIN(X); SBAR(); }while(0)
  #define VRD(i) do{ vlo[i]=vtr(vp_+(((i)>>2)*4096+((i)&3)*1024)); vhi[i]=vtr(vp_+(((i)>>2)*4096+((i)&3)*1024+512)); }while(0)
  #define KRD(G,j) do{ if(G){ kload2(kf,kp0+sl_next,j); SBAR(); } }while(0)
  #define STEP(C0,C1,P0,P1,t,GK,GV,GL) do{ SBAR(); \
    const lds_cptr vp_=vp0+sl_prev; \
    VRD(0); SBAR(); float sacc=(P0[0]+P0[1]); \
    GAPA(C0=__builtin_amdgcn_mfma_f32_32x32x16_bf16(kf[0],qr[0],negm,0,0,0), P0[2],P0[3],P0[4],P0[5],     pw0[0]=PKW(P0,0), pw0[1]=PKW(P0,2), pw0); \
    VRD(4); SBAR(); GAPA(C1=__builtin_amdgcn_mfma_f32_32x32x16_bf16(kf[1],qr[0],negm,0,0,0), P0[6],P0[7],P0[8],P0[9],     pw0[2]=PKW(P0,4), pw0[3]=PKW(P0,6), pw0); \
    VRD(1); SBAR(); GAPA(C0=__builtin_amdgcn_mfma_f32_32x32x16_bf16(kf[2],qr[1],C0,0,0,0),   P0[10],P0[11],P0[12],P0[13], pw1[0]=PKW(P0,8), pw1[1]=PKW(P0,10), pw1); \
    VRD(5); SBAR(); GAPA(C1=__builtin_amdgcn_mfma_f32_32x32x16_bf16(kf[3],qr[1],C1,0,0,0),   P0[14],P0[15],P1[0],P1[1],   pw1[2]=PKW(P0,12),pw1[3]=PKW(P0,14), pw1); \
    VRD(2); SBAR(); GAPA(C0=__builtin_amdgcn_mfma_f32_32x32x16_bf16(kf[4],qr[2],C0,0,0,0),   P1[2],P1[3],P1[4],P1[5],     pw2[0]=PKW(P1,0), pw2[1]=PKW(P1,2), pw2); \
    VRD(6); SBAR(); GAPA(C1=__builtin_amdgcn_mfma_f32_32x32x16_bf16(kf[5],qr[2],C1,0,0,0),   P1[6],P1[7],P1[8],P1[9],     pw2[2]=PKW(P1,4), pw2[3]=PKW(P1,6), pw2); \
    VRD(3); SBAR(); GAPA(C0=__builtin_amdgcn_mfma_f32_32x32x16_bf16(kf[6],qr[3],C0,0,0,0),   P1[10],P1[11],P1[12],P1[13], pw3[0]=PKW(P1,8), pw3[1]=PKW(P1,10), pw3); \
    VRD(7); SBAR(); GAPA(C1=__builtin_amdgcn_mfma_f32_32x32x16_bf16(kf[7],qr[3],C1,0,0,0),   P1[14],P1[15],0.f,0.f,       pw3[2]=PKW(P1,12),pw3[3]=PKW(P1,14), pw3); \
    l_reg+=sacc; \
    if(GK){DMA_K((t)+3,sl_cur);} if(GV){DMA_V((t)+1,sl_next);} \
    CMASK(C0,C1,t); \
    { float a=MX3(C0[0],C0[1],C1[0]),b=MX3(C0[2],C0[3],C1[1]); a=MX3(a,C1[2],C1[3]); \
      _Pragma("unroll") for(int r=4;r<16;r+=4){a=MX3(a,C0[r],C0[r+1]);b=MX3(b,C0[r+2],C0[r+3]);a=MX3(a,C1[r],C1[r+1]);b=MX3(b,C1[r+2],C1[r+3]);} \
      float rm=__builtin_fmaxf(a,b); { auto rr=__builtin_amdgcn_permlane32_swap(__float_as_uint(rm),__float_as_uint(rm),false,false); rm=__builtin_fmaxf(__uint_as_float(rr[0]),__uint_as_float(rr[1])); } \
      resc=false; \
      if(__builtin_expect(__any(rm>(float)THRL),0)){ const float dl=__builtin_fmaxf(rm,0.f); mhat+=dl; \
        _Pragma("unroll") for(int r=0;r<16;++r){C0[r]-=dl;C1[r]-=dl;} \
        _Pragma("unroll") for(int r=0;r<16;++r)negm[r]=-mhat; asm volatile("":"+v"(negm)); \
        const float f=__builtin_amdgcn_exp2f(-dl); l_reg*=f; if(hi==0)wsf[r32]=f; resc=true; } } \
    SBAR(); \
    GAPB(o[0]=__builtin_amdgcn_mfma_f32_32x32x16_bf16(PAF(0),VFR(0),o[0],0,0,0), C0,0); \
    GAPB(o[1]=__builtin_amdgcn_mfma_f32_32x32x16_bf16(PAF(0),VFR(4),o[1],0,0,0), C0,4); \
    KRD(GL,0); GAPB(o[0]=__builtin_amdgcn_mfma_f32_32x32x16_bf16(PAF(1),VFR(1),o[0],0,0,0), C0,8); \
    KRD(GL,1); GAPB(o[1]=__builtin_amdgcn_mfma_f32_32x32x16_bf16(PAF(1),VFR(5),o[1],0,0,0), C0,12); \
    KRD(GL,2); GAPB(o[0]=__builtin_amdgcn_mfma_f32_32x32x16_bf16(PAF(2),VFR(2),o[0],0,0,0), C1,0); \
    KRD(GL,3); GAPB(o[1]=__builtin_amdgcn_mfma_f32_32x32x16_bf16(PAF(2),VFR(6),o[1],0,0,0), C1,4); \
    GAPB(o[0]=__builtin_amdgcn_mfma_f32_32x32x16_bf16(PAF(3),VFR(3),o[0],0,0,0), C1,8); \
    GAPB(o[1]=__builtin_amdgcn_mfma_f32_32x32x16_bf16(PAF(3),VFR(7),o[1],0,0,0), C1,12); \
    }while(0)
  int t=1;
  #undef CMASK
  #define CMASK(P0,P1,t) do{}while(0)
  for(;t+5<NT;t+=2){
    STEP(pB0,pB1,pA0,pA1,t,true,true,true);     WAIT_BAR(2); RESC(); ROT();
    STEP(pA0,pA1,pB0,pB1,t+1,true,true,true);   WAIT_BAR(2); RESC(); ROT();
  }
  #undef CMASK
  #define CMASK(P0,P1,t) do{int jb_=(t)-(NT-4); if(jb_>=0)cmask(P0,P1,jb_,qrel,hi);}while(0)
  #define ENDW(tt) do{ if((tt)+3<NT){WAIT_BAR(2);} else if((tt)+2<NT){WAIT_BAR(1);} else {WAIT_BAR(0);} }while(0)
  for(;t+1<NT;t+=2){
    STEP(pB0,pB1,pA0,pA1,t,(t+3<NT),(t+1<NT),(t+1<NT));       ENDW(t);   RESC(); ROT();
    STEP(pA0,pA1,pB0,pB1,t+1,(t+4<NT),(t+2<NT),(t+2<NT));     ENDW(t+1); RESC(); ROT();
  }
  STEP(pB0,pB1,pA0,pA1,NT-1,false,false,false); RESC();
  { float sacc=pB0[0]+pB0[1]; _Pragma("unroll") for(int r=2;r<16;++r)sacc+=pB0[r]; _Pragma("unroll") for(int r=0;r<16;++r)sacc+=pB1[r]; l_reg+=sacc;
    pw0=(u32x4){PKW(pB0,0),PKW(pB0,2),PKW(pB0,4),PKW(pB0,6)};pw1=(u32x4){PKW(pB0,8),PKW(pB0,10),PKW(pB0,12),PKW(pB0,14)};pw2=(u32x4){PKW(pB1,0),PKW(pB1,2),PKW(pB1,4),PKW(pB1,6)};pw3=(u32x4){PKW(pB1,8),PKW(pB1,10),PKW(pB1,12),PKW(pB1,14)};
    SBAR(); pv(o,vb0+sl_cur,PAF(0),PAF(1),PAF(2),PAF(3)); }
  #undef PKW
  #undef PAF
  #undef VFR
  #undef PIN
  #undef MX3
  #undef GAPA
  #undef GAPB
  #undef EX
  #undef VRD
  #undef KRD
  #undef STEP
  #undef ENDW
  {auto rr=__builtin_amdgcn_permlane32_swap(__float_as_uint(l_reg),__float_as_uint(l_reg),false,false);l_reg=__uint_as_float(rr[0])+__uint_as_float(rr[1]);}
  if(hi==0)wsf[32+r32]=l_reg;asm volatile("s_waitcnt lgkmcnt(0)":::"memory");
  float rli[16];
  #pragma unroll
  for(int r=0;r<16;++r)rli[r]=__builtin_amdgcn_rcpf(wsf[32+crow(r,hi)]);
  bf16*Ow=O+(rowbase+q0+wid*QBLK)*OP+h*D;
  { bf16*stg=(bf16*)(shm+LDS_OST)+wid*2048;
    #pragma unroll
    for(int r=0;r<16;++r){const int orow=crow(r,hi);
      #pragma unroll
      for(int d0=0;d0<2;++d0)stg[orow*64+d0*32+r32]=__float2bfloat16(o[d0][r]*rli[r]);}
    asm volatile("s_waitcnt lgkmcnt(0)":::"memory");
    #pragma unroll
    for(int i=0;i<4;++i){const int row=i*8+(lane>>3),ch=lane&7; const u32x4 v=*(const u32x4*)(stg+row*64+ch*8); ATTN_STORE16(Ow+(long)row*OP+ch*8,v);} }
  asm volatile("s_waitcnt lgkmcnt(0)\n\ts_barrier":::"memory");
  #undef DMA_K
  #undef DMA_V
  #undef CMASK
  #undef START
  #undef RESC
  #undef ROT
}
constexpr int ATTN_LDS_BYTES=LDS_BYTES;
#undef SBAR
#undef WAIT_BAR
}

#define LAS __attribute__((address_space(3)))
typedef unsigned short bf16_t;
typedef short bf16x8 __attribute__((ext_vector_type(8)));
typedef short s16x4 __attribute__((ext_vector_type(4)));
typedef short v4i16_t __attribute__((ext_vector_type(4)));
typedef float f32x4 __attribute__((ext_vector_type(4)));
typedef float f32x16 __attribute__((ext_vector_type(16)));
typedef unsigned u32x4 __attribute__((ext_vector_type(4)));
typedef unsigned u32x2 __attribute__((ext_vector_type(2)));
typedef float f32x2 __attribute__((ext_vector_type(2)));
using pg8::Unit;

constexpr int NB = 8, S = 2048, M = NB * S, D = 1024, DEPTH = 4, INC = 8320, MEMLEN = 256, MM = NB * MEMLEN, FF = 4096;
constexpr int C_RQ = 0, C_RK = 512, C_RV = 1024, C_RG = 2048, C_LX = 3072, C_LY = 4096, C_GT = 5120;
constexpr size_t MiB = 1u << 20;
constexpr size_t WS_TAB = 1 * MiB, WS_RSM = 2 * MiB, WS_SLOT = 3 * MiB, WS_CARRY = 4 * MiB, WS_LRUW = 5 * MiB,
    WS_WIN = 6 * MiB, WS_WBR = 28 * MiB, WS_WOUT = 34 * MiB, WS_WQ = 36 * MiB, WS_WKV = 37 * MiB, WS_WO = 39 * MiB, WS_W1 = 40 * MiB, WS_W2 = 48 * MiB,
    WS_XB = 56 * MiB, WS_MEMB = 88 * MiB, WS_BR = 92 * MiB, WS_OD4 = 188 * MiB, WS_MERGED = 188 * MiB, WS_RETST = 252 * MiB, WS_U = 284 * MiB,
    WS_H = 284 * MiB, WS_QKVC = 544 * MiB, WS_QX = 640 * MiB, WS_KX = 656 * MiB, WS_VXT = 658 * MiB, WS_OX = 660 * MiB, WS_END = 676 * MiB;
constexpr size_t UBS = (size_t)2048 * INC;
constexpr size_t MBS = (size_t)2048 * 2048;
constexpr int LDS_BYTES = 147456, MISC_OFF = 147328;
constexpr float LOG2E = 1.4426950408889634f;
constexpr float C2 = 0.125f * LOG2E;
constexpr float CQ = 0.08838834764831845f * LOG2E;
constexpr float RSQ128 = 0.08838834764831845f;

struct Params { const float* in[27]; float* out; unsigned char* ws; };
typedef __attribute__((address_space(4))) const unsigned char* kaptr_t;
#define KA_GET(ka) kaptr_t ka = (kaptr_t)__builtin_amdgcn_kernarg_segment_ptr(); asm volatile("" : "+s"(ka));
#define GAS1 __attribute__((address_space(1)))
#define PIN(k) ((const float*)(*(const GAS1 float* const __attribute__((address_space(4)))*)(ka + 8 * (k))))
#define POUT ((float*)(*(GAS1 float* const __attribute__((address_space(4)))*)(ka + 216)))
#define PWS (*(GAS1 unsigned char* const __attribute__((address_space(4)))*)(ka + 224))
#define WSP(T, off) ((T*)(GAS1 T*)(ws + (off)))


__device__ __forceinline__ int tid_of(int wave_s) { int l; asm volatile("v_mbcnt_lo_u32_b32 %0, -1, 0\n\tv_mbcnt_hi_u32_b32 %0, -1, %0" : "=v"(l)); return wave_s * 64 + l; }
__device__ __forceinline__ unsigned pk2(float lo, float hi) { return pg8::cvt_pk_bf16(lo, hi); }
__device__ __forceinline__ bf16_t f2bf(float f) { return (bf16_t)(pk2(f, 0.f) & 0xffffu); }
__device__ __forceinline__ float bf2f(bf16_t u) { return __uint_as_float((unsigned)u << 16); }
__device__ __forceinline__ float bflo(unsigned w) { return __uint_as_float(w << 16); }
__device__ __forceinline__ float bfhi(unsigned w) { return __uint_as_float(w & 0xffff0000u); }
__device__ __forceinline__ float wave_sum(float v) {
#pragma unroll
    for (int o = 1; o < 64; o <<= 1) v += __shfl_xor(v, o);
    return v;
}
__device__ __forceinline__ float sigmoidf_(float x) { return __builtin_amdgcn_rcpf(1.f + __expf(-x)); }
__device__ __forceinline__ s16x4 ldtr(const LAS unsigned char* p) { return __builtin_bit_cast(s16x4, __builtin_amdgcn_ds_read_tr16_b64_v4i16((LAS v4i16_t*)p)); }
__device__ __forceinline__ bf16x8 cat8(s16x4 a, s16x4 b) { return (bf16x8){a[0], a[1], a[2], a[3], b[0], b[1], b[2], b[3]}; }
#define MFMA32(a, b, c) __builtin_amdgcn_mfma_f32_32x32x16_bf16((a), (b), (c), 0, 0, 0)
__device__ __forceinline__ int crow(int r, int hi) { return (r & 3) + 8 * (r >> 2) + 4 * hi; }

template <int R, int C> __device__ __forceinline__ void load_tile(LAS unsigned char* dst, int lp, const bf16_t* src, size_t gp, int tid) {
    constexpr int CPR = C / 8, TOT = R * CPR, NP = TOT / 512;
    u32x4 v[NP];
#pragma unroll
    for (int i = 0; i < NP; ++i) { const int idx = tid + i * 512, r = idx / CPR, ch = idx % CPR; v[i] = *(const u32x4*)(src + (size_t)r * gp + ch * 8); }
    asm volatile("" ::: "memory");
#pragma unroll
    for (int i = 0; i < NP; ++i) { const int idx = tid + i * 512, r = idx / CPR, ch = idx % CPR; *(LAS u32x4*)(dst + r * lp + ch * 16) = v[i]; }
}

__device__ __forceinline__ void tile_map(int L, int nM, int nN, int& pm, int& pn) {
    const int nwg = nM * nN; int wgid = L; { const int q = nwg / 8, r = nwg % 8, xcd = wgid % 8, off = wgid / 8; wgid = (xcd < r ? xcd * (q + 1) : r * (q + 1) + (xcd - r) * q) + off; }
    constexpr int GH = 4;
    const int nig = GH * nN, gid = wgid / nig, fm = gid * GH, gsz = (nM - fm) < GH ? (nM - fm) : GH;
    pm = fm + ((wgid % nig) % gsz); pn = (wgid % nig) / gsz;
}
struct SchedStd { const char* A; const char* B; int nM, nN, K, G, c; size_t a_bs; int rev = 0;
    __device__ __forceinline__ bool next(int i, Unit& u) const { const int L = i * G + c; if (L >= nM * nN) return false; int pm, pn; tile_map(L, nM, nN, pm, pn); if (rev) pn = nN - 1 - pn;
        u.pm = pm; u.pn = pn; u.aux = 0; u.a = A + (size_t)(pm >> 3) * a_bs + (size_t)(pm & 7) * 512 * K; u.b = B + (size_t)pn * 512 * K; return true; } };
struct SchedBranch { const char* BR; const char* W; int G, c;
    __device__ __forceinline__ bool next(int i, Unit& u) const { const int t = i / 3, j = i - 3 * t, L = t * G + c; if (L >= 256) return false; int pm, pn; tile_map(L, 64, 4, pm, pn);
        u.pm = pm; u.pn = pn; u.aux = j; u.a = BR + ((size_t)j * M + (size_t)pm * 256) * 2048; u.b = W + ((size_t)j * 1024 + (size_t)pn * 256) * 2048; return true; } };
struct SchedXA { const char* XB; const char* MEMB; const char* WQ; const char* WKV; int G, c;
    __device__ __forceinline__ bool next(int i, Unit& u) const { const int L = i * G + c; if (L >= 160) return false;
        if (L < 128) { int pm, pn; tile_map(L, 64, 2, pm, pn); u.pm = pm; u.pn = pn; u.aux = 0; u.a = XB + (size_t)pm * 524288; u.b = WQ + (size_t)pn * 524288; }
        else if (L < 144) { const int t = L - 128; u.pm = t & 7; u.pn = t >> 3; u.aux = 1; u.a = MEMB + (size_t)u.pm * 524288; u.b = WKV + (size_t)u.pn * 524288; }
        else { const int t = L - 144; u.pm = t >> 3; u.pn = t & 7; u.aux = 2; u.a = WKV + (size_t)(2 + u.pm) * 524288; u.b = MEMB + (size_t)u.pn * 524288; }
        return true; } };

__device__ __forceinline__ float slot_rstd(const float* slots, int row) {
    const f32x4* s = (const f32x4*)(slots + (size_t)row * 16); const f32x4 a = s[0], b = s[1], c = s[2], d = s[3];
    const float t = ((a.x + a.y) + (a.z + a.w)) + ((b.x + b.y) + (b.z + b.w)) + ((c.x + c.y) + (c.z + c.w)) + ((d.x + d.y) + (d.z + d.w));
    return rsqrtf(t * (1.f / 1024.f) + 1e-6f);
}
struct EpiWin { static constexpr bool PERM = true; bf16_t* U; bf16_t* QKVC; const float* slots; const float* tab; const LAS float* rsl; int rs_pm;
    __device__ __forceinline__ bool keep(const Unit&) const { return false; }
    __device__ __forceinline__ void operator()(f32x4 (&acc)[2][2][4][2], const Unit& u, int wr, int wc, int fr, int fq) const {
        const int pn = u.pn, row0 = u.pm * 256 + wr * 64 + fr, colw = wc * 32 + 8 * fq;
        float cs = 1.f; if (pn < 4) cs = C2; else if (pn == 14 || pn == 15) cs = RSQ128;
        const bool rot = (pn >= 12 && pn < 16);
        f32x4 tq[2][2];
#define ROT_ISSUE(g, buf) do { const f32x4* tp_ = (const f32x4*)(tab + ((size_t)((row0 + ((g) >> 2) * 128 + ((g) & 3) * 16) & 2047) * 64 + (colw >> 1)) * 2); tq[buf][0] = tp_[0]; tq[buf][1] = tp_[1]; } while (0)
        tq[0][0] = (f32x4){1.f, 0.f, 1.f, 0.f}; tq[0][1] = tq[0][0]; tq[1][0] = tq[0][0]; tq[1][1] = tq[0][0];
        if (rot) ROT_ISSUE(0, 0);
#pragma unroll
        for (int g = 0; g < 8; ++g) { const int ai = g >> 2, m = g & 3;
            { const int row = row0 + ai * 128 + m * 16; const float rs = ((u.pm & ~4) == rs_pm ? rsl[((u.pm >> 2) & 1) * 256 + wr * 64 + fr + ai * 128 + m * 16] : slot_rstd(slots, row)) * cs;
                if (rot && g + 1 < 8) ROT_ISSUE(g + 1, (g + 1) & 1);
                const f32x4 t0 = tq[g & 1][0], t1 = tq[g & 1][1];
#pragma unroll
                for (int bj = 0; bj < 2; ++bj) { f32x4 v0 = acc[ai][bj][m][0] * rs, v1 = acc[ai][bj][m][1] * rs;
                    if (rot) { const f32x4 a0 = v0, a1 = v1;
                        v0.x = a0.x * t0.x - a0.y * t0.y; v0.y = a0.y * t0.x + a0.x * t0.y; v0.z = a0.z * t0.z - a0.w * t0.w; v0.w = a0.w * t0.z + a0.z * t0.w;
                        v1.x = a1.x * t1.x - a1.y * t1.y; v1.y = a1.y * t1.x + a1.x * t1.y; v1.z = a1.z * t1.z - a1.w * t1.w; v1.w = a1.w * t1.z + a1.z * t1.w; }
                    u32x4 w; w.x = pk2(v0.x, v0.y); w.y = pk2(v0.z, v0.w); w.z = pk2(v1.x, v1.y); w.w = pk2(v1.z, v1.w);
                    bf16_t* dst;
                    if (pn < 12) { const int hh = (pn & 3) * 2 + bj, c = colw >> 6, d = colw & 63, b = row >> 11, sq = row & 2047;
                        dst = QKVC + (size_t)(pn >> 2) * ((size_t)M * 1024) + ((size_t)((b * 8 + hh) * 2 + c) * 2048 + sq) * 64 + d; }
                    else dst = U + (size_t)row * INC + (pn - 12) * 256 + bj * 128 + colw;
                    *(u32x4*)dst = w; } } }
#undef ROT_ISSUE
    }
};
struct EpiResid { static constexpr bool PERM = true; const float* base; float* out; bf16_t* XB; float* slots;
    __device__ __forceinline__ bool keep(const Unit&) const { return false; }
    __device__ __forceinline__ void operator()(f32x4 (&acc)[2][2][4][2], const Unit& u, int wr, int wc, int fr, int fq) const {
        const int pn = u.pn, row0 = u.pm * 256 + wr * 64 + fr, colw = wc * 32 + 8 * fq;
        f32x4 r[2][4];
#define RES_ISSUE(g, buf) do { const size_t off_ = (size_t)(row0 + ((g) >> 2) * 128 + ((g) & 3) * 16) * D + pn * 256 + colw; \
        r[buf][0] = *(const f32x4*)(base + off_); r[buf][1] = *(const f32x4*)(base + off_ + 4); r[buf][2] = *(const f32x4*)(base + off_ + 128); r[buf][3] = *(const f32x4*)(base + off_ + 132); } while (0)
        RES_ISSUE(0, 0);
#pragma unroll
        for (int g = 0; g < 8; ++g) { const int ai = g >> 2, m = g & 3, row = row0 + ai * 128 + m * 16; float ss = 0.f;
            if (g + 1 < 8) RES_ISSUE(g + 1, (g + 1) & 1);
#pragma unroll
            for (int bj = 0; bj < 2; ++bj) { const size_t off = (size_t)row * D + pn * 256 + bj * 128 + colw;
                const f32x4 o0 = r[g & 1][2 * bj] + acc[ai][bj][m][0], o1 = r[g & 1][2 * bj + 1] + acc[ai][bj][m][1];
                *(f32x4*)(out + off) = o0; *(f32x4*)(out + off + 4) = o1;
                u32x4 w; w.x = pk2(o0.x, o0.y); w.y = pk2(o0.z, o0.w); w.z = pk2(o1.x, o1.y); w.w = pk2(o1.z, o1.w); *(u32x4*)(XB + off) = w;
                ss += (o0.x * o0.x + o0.y * o0.y) + (o0.z * o0.z + o0.w * o0.w) + (o1.x * o1.x + o1.y * o1.y) + (o1.z * o1.z + o1.w * o1.w); }
            ss += __shfl_xor(ss, 16); ss += __shfl_xor(ss, 32);
            if (fq == 0) slots[(size_t)row * 16 + pn * 4 + wc] = ss; }
#undef RES_ISSUE
    }
};
struct EpiW1 { static constexpr bool PERM = true; bf16_t* H; const float* slots; const LAS float* rsl; int rs_pm;
    __device__ __forceinline__ bool keep(const Unit&) const { return false; }
    __device__ __forceinline__ void operator()(f32x4 (&acc)[2][2][4][2], const Unit& u, int wr, int wc, int fr, int fq) const {
        const int pn = u.pn, row0 = u.pm * 256 + wr * 64 + fr, colw = wc * 32 + 8 * fq;
#pragma unroll
        for (int ai = 0; ai < 2; ++ai)
#pragma unroll
            for (int m = 0; m < 4; ++m) { const int row = row0 + ai * 128 + m * 16; const float rs = (u.pm & ~4) == rs_pm ? rsl[((u.pm >> 2) & 1) * 256 + wr * 64 + fr + ai * 128 + m * 16] : slot_rstd(slots, row);
#pragma unroll
                for (int bj = 0; bj < 2; ++bj) { f32x4 v0 = acc[ai][bj][m][0] * rs, v1 = acc[ai][bj][m][1] * rs;
                    v0 = __builtin_elementwise_max(v0, (f32x4){0.f, 0.f, 0.f, 0.f}); v1 = __builtin_elementwise_max(v1, (f32x4){0.f, 0.f, 0.f, 0.f}); v0 = v0 * v0; v1 = v1 * v1;
                    u32x4 w; w.x = pk2(v0.x, v0.y); w.y = pk2(v0.z, v0.w); w.z = pk2(v1.x, v1.y); w.w = pk2(v1.z, v1.w);
                    *(u32x4*)(H + (size_t)(row >> 11) * UBS + (size_t)(row & 2047) * FF + pn * 256 + bj * 128 + colw) = w; } }
    }
};
struct EpiXA { static constexpr bool PERM = true; bf16_t* QX; bf16_t* KX; bf16_t* VXT; const float* slots; const float* rsm; const LAS float* rsl;
    __device__ __forceinline__ bool keep(const Unit&) const { return false; }
    __device__ __forceinline__ void operator()(f32x4 (&acc)[2][2][4][2], const Unit& u, int wr, int wc, int fr, int fq) const {
        const int pn = u.pn, row0 = u.pm * 256 + wr * 64 + fr, colw = wc * 32 + 8 * fq, aux = u.aux;
        float rs[8]; f32x4 cv[2][2];
#pragma unroll
        for (int g = 0; g < 8; ++g) { const int row = row0 + (g >> 2) * 128 + (g & 3) * 16; rs[g] = aux == 0 ? rsl[wr * 64 + fr + (g >> 2) * 128 + (g & 3) * 16] * CQ : aux == 1 ? rsm[row] : 1.f; }
#pragma unroll
        for (int bj = 0; bj < 2; ++bj) { const int col = pn * 256 + bj * 128 + colw; cv[bj][0] = (f32x4){1.f, 1.f, 1.f, 1.f}; cv[bj][1] = cv[bj][0];
            if (aux == 2) { cv[bj][0] = *(const f32x4*)(rsm + col); cv[bj][1] = *(const f32x4*)(rsm + col + 4); } }
#pragma unroll
        for (int g = 0; g < 8; ++g) { const int ai = g >> 2, m = g & 3, row = row0 + ai * 128 + m * 16;
#pragma unroll
            for (int bj = 0; bj < 2; ++bj) { const int col = pn * 256 + bj * 128 + colw; const f32x4 v0 = acc[ai][bj][m][0] * rs[g] * cv[bj][0], v1 = acc[ai][bj][m][1] * rs[g] * cv[bj][1];
                u32x4 w; w.x = pk2(v0.x, v0.y); w.y = pk2(v0.z, v0.w); w.z = pk2(v1.x, v1.y); w.w = pk2(v1.z, v1.w);
                bf16_t* dst = aux == 0 ? QX + (size_t)row * 512 + col : aux == 1 ? KX + (size_t)row * 512 + col : VXT + (size_t)row * 2048 + col;
                *(u32x4*)dst = w; } }
    }
};
struct EpiBranch { static constexpr bool PERM = true; const bf16_t* U; bf16_t* MG;
    __device__ __forceinline__ bool keep(const Unit& u) const { return u.aux < 2; }
    __device__ __forceinline__ void operator()(f32x4 (&acc)[2][2][4][2], const Unit& u, int wr, int wc, int fr, int fq) const {
        const int pn = u.pn, row0 = u.pm * 256 + wr * 64 + fr, colw = wc * 32 + 8 * fq, j = u.aux;
        if (j < 2) {
            u32x4 gm[2][4];
#define BRM_ISSUE(g, buf) do { const bf16_t* gp_ = U + (size_t)(row0 + ((g) >> 2) * 128 + ((g) & 3) * 16) * INC + C_GT + j * 1024 + pn * 256 + colw; \
            gm[buf][0] = *(const u32x4*)gp_; gm[buf][1] = *(const u32x4*)(gp_ + 1024); gm[buf][2] = *(const u32x4*)(gp_ + 128); gm[buf][3] = *(const u32x4*)(gp_ + 128 + 1024); } while (0)
            BRM_ISSUE(0, 0);
#pragma unroll
            for (int g = 0; g < 8; ++g) { const int ai = g >> 2, m = g & 3;
                if (g + 1 < 8) BRM_ISSUE(g + 1, (g + 1) & 1);
#pragma unroll
                for (int bj = 0; bj < 2; ++bj) { const u32x4 g0 = gm[g & 1][2 * bj], g1 = gm[g & 1][2 * bj + 1]; f32x4 s0, s1;
#define RT(a, b) ((1.f + __expf(-(b))) * __builtin_amdgcn_rcpf(1.f + __expf(-(a))))
                    s0.x = RT(bflo(g0.x), bflo(g1.x)); s0.y = RT(bfhi(g0.x), bfhi(g1.x)); s0.z = RT(bflo(g0.y), bflo(g1.y)); s0.w = RT(bfhi(g0.y), bfhi(g1.y));
                    s1.x = RT(bflo(g0.z), bflo(g1.z)); s1.y = RT(bfhi(g0.z), bfhi(g1.z)); s1.z = RT(bflo(g0.w), bflo(g1.w)); s1.w = RT(bfhi(g0.w), bfhi(g1.w));
#undef RT
                    acc[ai][bj][m][0] = acc[ai][bj][m][0] * s0; acc[ai][bj][m][1] = acc[ai][bj][m][1] * s1; }
                asm volatile("" ::: "memory"); }
#undef BRM_ISSUE
        } else {
            u32x4 gq[2][2];
#define BR_ISSUE(g, buf) do { const bf16_t* gp_ = U + (size_t)(row0 + ((g) >> 2) * 128 + ((g) & 3) * 16) * INC + C_GT + 2 * 1024 + pn * 256 + colw; gq[buf][0] = *(const u32x4*)gp_; gq[buf][1] = *(const u32x4*)(gp_ + 128); } while (0)
            BR_ISSUE(0, 0);
#pragma unroll
            for (int g = 0; g < 8; ++g) { const int ai = g >> 2, m = g & 3, row = row0 + ai * 128 + m * 16;
                if (g + 1 < 8) BR_ISSUE(g + 1, (g + 1) & 1);
#pragma unroll
                for (int bj = 0; bj < 2; ++bj) { const int col = pn * 256 + bj * 128 + colw; const u32x4 g0 = gq[g & 1][bj]; f32x4 s0, s1;
                    s0.x = sigmoidf_(bflo(g0.x)); s0.y = sigmoidf_(bfhi(g0.x)); s0.z = sigmoidf_(bflo(g0.y)); s0.w = sigmoidf_(bfhi(g0.y));
                    s1.x = sigmoidf_(bflo(g0.z)); s1.y = sigmoidf_(bfhi(g0.z)); s1.z = sigmoidf_(bflo(g0.w)); s1.w = sigmoidf_(bfhi(g0.w));
                    const f32x4 v0 = acc[ai][bj][m][0] * s0, v1 = acc[ai][bj][m][1] * s1;
                    u32x4 w; w.x = pk2(v0.x, v0.y); w.y = pk2(v0.z, v0.w); w.z = pk2(v1.x, v1.y); w.w = pk2(v1.z, v1.w);
                    *(u32x4*)(MG + (size_t)(row >> 11) * MBS + (size_t)(row & 2047) * D + col) = w; } }
#undef BR_ISSUE
        }
    }
};

__device__ __forceinline__ void transpose_item(const float* W, const float* g, int K, int N, bf16_t* WT, int row_off, LAS float* scr, int item, int lane) {
    const int nblk = N / 64, kb = item / nblk, nb = item % nblk, k0 = 64 * kb, n0 = 64 * nb;
    f32x4 wv[16]; float gv[16];
#pragma unroll
    for (int i = 0; i < 16; ++i) { const int kk = 4 * i + (lane >> 4), nn = (lane & 15) * 4; gv[i] = g ? g[k0 + kk] : 1.f; wv[i] = *(const f32x4*)(W + (size_t)(k0 + kk) * N + n0 + nn); }
    asm volatile("" ::: "memory");
#pragma unroll
    for (int i = 0; i < 16; ++i) { const int kk = 4 * i + (lane >> 4), nn = (lane & 15) * 4; const f32x4 v = wv[i] * gv[i]; LAS float* d = scr + kk * 65 + nn; d[0] = v.x; d[1] = v.y; d[2] = v.z; d[3] = v.w; }
    asm volatile("s_waitcnt lgkmcnt(0)" ::: "memory");
    const int c = lane & 7;
#pragma unroll
    for (int j = 0; j < 8; ++j) { const int n = (lane >> 3) + 8 * j; const LAS float* s = scr + (8 * c) * 65 + n;
        u32x4 o; o.x = pk2(s[0 * 65], s[1 * 65]); o.y = pk2(s[2 * 65], s[3 * 65]); o.z = pk2(s[4 * 65], s[5 * 65]); o.w = pk2(s[6 * 65], s[7 * 65]);
        *(u32x4*)(WT + (size_t)(row_off + n0 + n) * K + k0 + 8 * c) = o; }
    asm volatile("s_waitcnt lgkmcnt(0)" ::: "memory");
}
__device__ __forceinline__ float row_to_bf16(const float* xrow, bf16_t* orow, int lane) {
    const f32x4* xr = (const f32x4*)xrow + lane; f32x4 v[4]; float s = 0.f;
#pragma unroll
    for (int j = 0; j < 4; ++j) { v[j] = xr[64 * j]; s += (v[j].x * v[j].x + v[j].y * v[j].y) + (v[j].z * v[j].z + v[j].w * v[j].w); }
    u32x2* o8 = (u32x2*)orow + lane;
#pragma unroll
    for (int j = 0; j < 4; ++j) { u32x2 w; w.x = pk2(v[j].x, v[j].y); w.y = pk2(v[j].z, v[j].w); o8[64 * j] = w; }
    return wave_sum(s);
}

__device__ __forceinline__ void conv_set(kaptr_t ka, GAS1 unsigned char* ws, int l, int set, int gwi, int ngw, LAS float* scr, int lane) {
    constexpr int I_IN = 16 * 176, I_SQ = 256, I_Q = 128, I_KV = 256, I_O = 128, I_1 = 1024, I_2 = 1024, I_L = 4;
    const int nit = set == 0 ? I_IN : set == 1 ? (3 * I_SQ + I_SQ + I_Q + I_KV + 16 * I_L) : (I_O + I_1 + I_2);
#pragma unroll 1
    for (int it = gwi; it < nit; it += ngw) {
        int r = it; const float* W; const float* g = nullptr; int K = 1024, N = 1024, ro = 0; bf16_t* WT;
        if (set == 0) { W = PIN(3) + (size_t)l * 1024 * 11264; g = PIN(2) + l * 1024; N = 11264; WT = WSP(bf16_t, WS_WIN); }
        else if (set == 1) {
            if (r < 3 * I_SQ) { const int j = r / I_SQ; r -= j * I_SQ; W = PIN(16) + (size_t)(l * 3 + j) * 1024 * 1024; WT = WSP(bf16_t, WS_WBR); ro = j * 1024; }
            else if ((r -= 3 * I_SQ) < I_SQ) { W = PIN(17) + (size_t)l * 1024 * 1024; WT = WSP(bf16_t, WS_WOUT); }
            else if ((r -= I_SQ) < I_Q) { W = PIN(20) + (size_t)l * 1024 * 512; g = PIN(18) + l * 1024; N = 512; WT = WSP(bf16_t, WS_WQ); }
            else if ((r -= I_Q) < I_KV) { W = PIN(21) + (size_t)l * 1024 * 1024; g = PIN(19) + l * 1024; WT = WSP(bf16_t, WS_WKV); }
            else { r -= I_KV; const int blk = r / I_L, which = blk >> 3, n = blk & 7; r -= blk * I_L; W = (which ? PIN(13) : PIN(11)) + (size_t)(l * 8 + n) * 16384; K = 128; N = 128; WT = WSP(bf16_t, WS_LRUW) + (size_t)blk * 16384; }
        } else {
            if (r < I_O) { W = PIN(22) + (size_t)l * 512 * 1024; K = 512; WT = WSP(bf16_t, WS_WO); }
            else if ((r -= I_O) < I_1) { W = PIN(24) + (size_t)l * 1024 * 4096; g = PIN(23) + l * 1024; N = 4096; WT = WSP(bf16_t, WS_W1); }
            else { r -= I_1; W = PIN(25) + (size_t)l * 4096 * 1024; K = 4096; WT = WSP(bf16_t, WS_W2); }
        }
        transpose_item(W, g, K, N, WT, ro, scr, r, lane);
    }
}

__device__ __forceinline__ void ret_state_unit(const bf16_t* U, bf16_t* ST, int unit, LAS unsigned char* lds, int tid, int lane, int wave) {
    const int es = unit & 3, bh = unit >> 2, h = bh & 3, b = bh >> 2;
    const float lg = log2f(1.f - exp2f(-5.f - (float)h)), cdec = exp2f(128.f * lg);
    LAS unsigned char* Kc = lds; LAS unsigned char* Vc = lds + 34816;
    const int dt = wave & 3, et = wave >> 2, r32 = lane & 31, hi = lane >> 5, g = lane >> 4, q4 = (lane & 15) >> 2, p4 = lane & 3;
    f32x16 st = {};
    const bf16_t* Ub = U + (size_t)b * S * INC;
    u32x4 pk_[4], pv_[2];
#define RS_FETCH(nn) do { _Pragma("unroll") for (int i = 0; i < 4; ++i) { const int idx = tid + i * 512; pk_[i] = *(const u32x4*)(Ub + (size_t)((nn) * 128 + (idx >> 4)) * INC + C_RK + h * 128 + (idx & 15) * 8); } \
        _Pragma("unroll") for (int i = 0; i < 2; ++i) { const int idx = tid + i * 512; pv_[i] = *(const u32x4*)(Ub + (size_t)((nn) * 128 + (idx >> 3)) * INC + C_RV + h * 256 + es * 64 + (idx & 7) * 8); } } while (0)
    RS_FETCH(0);
#pragma unroll 1
    for (int n = 0; n < 16; ++n) {
        __syncthreads();
#pragma unroll
        for (int i = 0; i < 4; ++i) { const int idx = tid + i * 512; *(LAS u32x4*)(Kc + (idx >> 4) * 272 + (idx & 15) * 16) = pk_[i]; }
#pragma unroll
        for (int i = 0; i < 2; ++i) { const int idx = tid + i * 512, r = idx >> 3, ch = idx & 7; const u32x4 v = pv_[i]; const float w = exp2f((float)(127 - r) * lg);
            u32x4 o; o.x = pk2(bflo(v.x) * w, bfhi(v.x) * w); o.y = pk2(bflo(v.y) * w, bfhi(v.y) * w); o.z = pk2(bflo(v.z) * w, bfhi(v.z) * w); o.w = pk2(bflo(v.w) * w, bfhi(v.w) * w);
            *(LAS u32x4*)(Vc + r * 144 + ch * 16) = o; }
        __syncthreads();
        if (n < 15) RS_FETCH(n + 1);
        bf16_t* sp = ST + ((size_t)(bh * 16 + n) * 256 + es * 64 + et * 32 + r32) * 128 + dt * 32 + 4 * hi;
#pragma unroll
        for (int g4 = 0; g4 < 4; ++g4) { u32x2 w; w.x = pk2(st[4 * g4], st[4 * g4 + 1]); w.y = pk2(st[4 * g4 + 2], st[4 * g4 + 3]); *(u32x2*)(sp + 8 * g4) = w; }
        f32x16 kv = {};
#pragma unroll
        for (int kk = 0; kk < 8; ++kk) {
            const LAS unsigned char* ka = Kc + (16 * kk + 8 * hi + q4) * 272 + (dt * 32 + 16 * (g & 1) + 4 * p4) * 2;
            const bf16x8 a = cat8(ldtr(ka), ldtr(ka + 4 * 272));
            const LAS unsigned char* va = Vc + (16 * kk + 8 * hi + q4) * 144 + (et * 32 + 16 * (g & 1) + 4 * p4) * 2;
            const bf16x8 bb = cat8(ldtr(va), ldtr(va + 4 * 144));
            kv = MFMA32(a, bb, kv); }
        st = st * cdec + kv;
    }
#undef RS_FETCH
}
__device__ __forceinline__ void ret_out_unit(const bf16_t* U, const bf16_t* ST, bf16_t* BR1, int unit, LAS unsigned char* lds, int tid, int lane_, int wave) {
    asm volatile("" : "+v"(tid)); const int lane = tid & 63; (void)lane_;
    const int n = unit & 15, bh = unit >> 4, h = bh & 3, b = bh >> 2;
    const float lg = log2f(1.f - exp2f(-5.f - (float)h));
    LAS unsigned char* Qs = lds; LAS unsigned char* Ks = lds + 34816; LAS unsigned char* Vs = lds + 69632;
    const int r32 = lane & 31, hi = lane >> 5, g = lane >> 4, q4 = (lane & 15) >> 2, p4 = lane & 3;
    const size_t tok0 = (size_t)b * S + n * 128;
    __syncthreads();
    load_tile<128, 128>(Qs, 272, U + tok0 * INC + C_RQ + h * 128, INC, tid); __builtin_amdgcn_sched_barrier(0);
    load_tile<128, 128>(Ks, 272, U + tok0 * INC + C_RK + h * 128, INC, tid); __builtin_amdgcn_sched_barrier(0);
    load_tile<128, 256>(Vs, 528, U + tok0 * INC + C_RV + h * 256, INC, tid);
    __syncthreads();
    const int ct = wave & 3, mt0 = (wave >> 2) * 2;
    f32x16 s[2]; s[0] = (f32x16){}; s[1] = (f32x16){};
#pragma unroll
    for (int j = 0; j < 2; ++j) { const int mt = mt0 + j;
        if (mt <= ct) {
#pragma unroll
            for (int kk = 0; kk < 8; ++kk) { const bf16x8 a = *(const LAS bf16x8*)(Qs + (ct * 32 + r32) * 272 + (16 * kk + 8 * hi) * 2);
                const bf16x8 bb = *(const LAS bf16x8*)(Ks + (mt * 32 + r32) * 272 + (16 * kk + 8 * hi) * 2); s[j] = MFMA32(a, bb, s[j]); __builtin_amdgcn_sched_barrier(0); } } }
    __syncthreads();
#pragma unroll
    for (int j = 0; j < 2; ++j) { const int mt = mt0 + j;
#pragma unroll
        for (int r = 0; r < 16; ++r) { const int c = ct * 32 + crow(r, hi), m = mt * 32 + r32, dl = c - m; const float val = dl >= 0 ? s[j][r] * exp2f((float)dl * lg) : 0.f;
            *(LAS bf16_t*)(Ks + c * 272 + m * 2) = f2bf(val); } }
#pragma unroll
    for (int i = 0; i < 4; ++i) { const int idx = tid + i * 512, r = idx >> 4, ch = idx & 15; const float w = exp2f((float)(r + 1) * lg);
        LAS u32x4* qp = (LAS u32x4*)(Qs + r * 272 + ch * 16); const u32x4 v = *qp;
        u32x4 o; o.x = pk2(bflo(v.x) * w, bfhi(v.x) * w); o.y = pk2(bflo(v.y) * w, bfhi(v.y) * w); o.z = pk2(bflo(v.z) * w, bfhi(v.z) * w); o.w = pk2(bflo(v.w) * w, bfhi(v.w) * w); *qp = o; }
    __syncthreads();
    f32x16 oi[4];
#pragma unroll
    for (int c4 = 0; c4 < 4; ++c4) oi[c4] = (f32x16){};
    const bf16_t* stp = ST + ((size_t)unit * 256 + 32 * wave + r32) * 128 + 8 * hi;
#pragma unroll
    for (int kk = 0; kk < 8; ++kk) { const LAS unsigned char* va = Vs + (16 * kk + 8 * hi + q4) * 528 + (32 * wave + 16 * (g & 1) + 4 * p4) * 2;
        const bf16x8 bb = cat8(ldtr(va), ldtr(va + 4 * 528));
#pragma unroll
        for (int c4 = 0; c4 < 4; ++c4) { const bf16x8 a = *(const LAS bf16x8*)(Ks + (c4 * 32 + r32) * 272 + (16 * kk + 8 * hi) * 2); oi[c4] = MFMA32(a, bb, oi[c4]); } __builtin_amdgcn_sched_barrier(0); }
#pragma unroll
    for (int k4 = 0; k4 < 8; k4 += 4) { bf16x8 stf[4];
#pragma unroll
        for (int kq = 0; kq < 4; ++kq) stf[kq] = *(const bf16x8*)(stp + 16 * (k4 + kq));
#pragma unroll
        for (int kq = 0; kq < 4; ++kq) { const int kk = k4 + kq;
#pragma unroll
            for (int c4 = 0; c4 < 4; ++c4) { const bf16x8 a = *(const LAS bf16x8*)(Qs + (c4 * 32 + r32) * 272 + (16 * kk + 8 * hi) * 2); oi[c4] = MFMA32(a, stf[kq], oi[c4]); } }
        __builtin_amdgcn_sched_barrier(0); }
    __syncthreads();
    LAS unsigned char* Of = lds;
#pragma unroll
    for (int c4 = 0; c4 < 4; ++c4)
#pragma unroll
        for (int r = 0; r < 16; ++r) { const int c = c4 * 32 + crow(r, hi); *(LAS float*)(Of + c * 1040 + (32 * wave + r32) * 4) = oi[c4][r]; }
    __syncthreads();
    { const int row = tid >> 2, qd = tid & 3; f32x4 v[16]; float sm = 0.f;
      const bf16_t* rgp = U + (tok0 + row) * INC + C_RG + h * 256 + qd * 64; u32x4 gvv[8];
#pragma unroll
      for (int k = 0; k < 8; ++k) gvv[k] = *(const u32x4*)(rgp + ((k + 2 * qd) & 7) * 8);
#pragma unroll
      for (int i = 0; i < 16; ++i) { const int ch = (i + 4 * qd) & 15; v[i] = *(const LAS f32x4*)(Of + row * 1040 + qd * 256 + ch * 16); sm += (v[i].x + v[i].y) + (v[i].z + v[i].w); }
      sm += __shfl_xor(sm, 1); sm += __shfl_xor(sm, 2); const float mean = sm * (1.f / 256.f); float q = 0.f;
#pragma unroll
      for (int i = 0; i < 16; ++i) { v[i] = v[i] - mean; q += (v[i].x * v[i].x + v[i].y * v[i].y) + (v[i].z * v[i].z + v[i].w * v[i].w); }
      q += __shfl_xor(q, 1); q += __shfl_xor(q, 2); const float rstd = rsqrtf(q * (1.f / 256.f) + 1e-5f);
      bf16_t* op = BR1 + (tok0 + row) * D + h * 256 + qd * 64;
#pragma unroll
      for (int k = 0; k < 8; ++k) { const int grp = (k + 2 * qd) & 7; const u32x4 gv = gvv[k]; const f32x4 a = v[2 * k] * rstd, c = v[2 * k + 1] * rstd;
#define SILU(x) ((x) * sigmoidf_(x))
          u32x4 w; w.x = pk2(SILU(bflo(gv.x)) * a.x, SILU(bfhi(gv.x)) * a.y); w.y = pk2(SILU(bflo(gv.y)) * a.z, SILU(bfhi(gv.y)) * a.w);
          w.z = pk2(SILU(bflo(gv.z)) * c.x, SILU(bfhi(gv.z)) * c.y); w.w = pk2(SILU(bflo(gv.w)) * c.z, SILU(bfhi(gv.w)) * c.w);
#undef SILU
          *(u32x4*)(op + grp * 8) = w; __builtin_amdgcn_sched_barrier(0); } }
}

template <bool FINAL> __device__ __forceinline__ void lru_unit(kaptr_t ka, int l, const bf16_t* U, float2* CARRY, bf16_t* BR2, const bf16_t* LW, int unit, LAS unsigned char* lds, int tid, int lane, int wave) {
    const int n = unit & 7, tc = (unit >> 3) & 15, b = unit >> 7;
    LAS unsigned char* Xc = lds; LAS unsigned char* Wa = lds + 34816; LAS unsigned char* Wx = lds + 69632;
    LAS unsigned char* A_ = lds; LAS unsigned char* B_ = lds + 67584; LAS f32x2* SEG = (LAS f32x2*)(lds + 135168);
    const size_t tok0 = (size_t)b * S + tc * 128;
    const int r32 = lane & 31, hi = lane >> 5;
    __syncthreads();
    load_tile<128, 128>(Wa, 272, LW + (size_t)n * 16384, 128, tid);
    load_tile<128, 128>(Wx, 272, LW + (size_t)(8 + n) * 16384, 128, tid);
    { const float* cw = PIN(9) + (size_t)l * 4096; const float* cb = PIN(10) + (size_t)l * 1024;
#pragma unroll
      for (int i = 0; i < 4; ++i) { const int idx = tid + i * 512, t = idx >> 4, c0 = n * 128 + (idx & 15) * 8;
          f32x4 a0 = *(const f32x4*)(cb + c0), a1 = *(const f32x4*)(cb + c0 + 4);
#pragma unroll
          for (int j = 0; j < 4; ++j) { const int ts = tc * 128 + t - 3 + j;
              if (ts >= 0) { const u32x4 xv = *(const u32x4*)(U + ((size_t)b * S + ts) * INC + C_LX + c0); const f32x4 w0 = *(const f32x4*)(cw + j * 1024 + c0), w1 = *(const f32x4*)(cw + j * 1024 + c0 + 4);
                  a0.x += w0.x * bflo(xv.x); a0.y += w0.y * bfhi(xv.x); a0.z += w0.z * bflo(xv.y); a0.w += w0.w * bfhi(xv.y);
                  a1.x += w1.x * bflo(xv.z); a1.y += w1.y * bfhi(xv.z); a1.z += w1.z * bflo(xv.w); a1.w += w1.w * bfhi(xv.w); } }
          u32x4 o; o.x = pk2(a0.x, a0.y); o.y = pk2(a0.z, a0.w); o.z = pk2(a1.x, a1.y); o.w = pk2(a1.z, a1.w);
          *(LAS u32x4*)(Xc + t * 272 + (idx & 15) * 16) = o; } }
    __syncthreads();
    const int tt = wave & 3, dt0 = (wave >> 2) * 2;
    f32x16 ra[2], ia[2]; ra[0] = (f32x16){}; ra[1] = (f32x16){}; ia[0] = (f32x16){}; ia[1] = (f32x16){};
#pragma unroll
    for (int kk = 0; kk < 8; ++kk) { const bf16x8 a = *(const LAS bf16x8*)(Xc + (tt * 32 + r32) * 272 + (16 * kk + 8 * hi) * 2);
#pragma unroll
        for (int j = 0; j < 2; ++j) { const int ro = ((dt0 + j) * 32 + r32) * 272 + (16 * kk + 8 * hi) * 2;
            ra[j] = MFMA32(a, *(const LAS bf16x8*)(Wa + ro), ra[j]); ia[j] = MFMA32(a, *(const LAS bf16x8*)(Wx + ro), ia[j]); } }
#pragma unroll
    for (int j = 0; j < 2; ++j) { const int ch = (dt0 + j) * 32 + r32, gch = l * 1024 + n * 128 + ch;
        const float ba = PIN(12)[gch], bx = PIN(14)[gch], sp = __logf(1.f + __expf(-PIN(15)[gch]));
#pragma unroll
        for (int r = 0; r < 16; ++r) { const int t = tt * 32 + crow(r, hi); const float xc = bf2f(*(const LAS bf16_t*)(Xc + t * 272 + ch * 2));
            const float rr = sigmoidf_(ra[j][r] + ba), ii = sigmoidf_(ia[j][r] + bx), la = -8.f * rr * sp, av = __expf(la), mult = sqrtf(fmaxf(1.f - __expf(2.f * la), 0.f));
            ra[j][r] = av; ia[j][r] = mult * ii * xc; } }
    __syncthreads();
#pragma unroll
    for (int j = 0; j < 2; ++j) { const int ch = (dt0 + j) * 32 + r32;
#pragma unroll
        for (int r = 0; r < 16; ++r) { const int t = tt * 32 + crow(r, hi); *(LAS float*)(A_ + t * 528 + ch * 4) = ra[j][r]; *(LAS float*)(B_ + t * 528 + ch * 4) = ia[j][r]; } }
    __syncthreads();
    const int ch = tid & 127, seg = tid >> 7;
    { float Ac = 1.f, Bc = 0.f;
      for (int t = seg * 32; t < seg * 32 + 32; ++t) { const float av = *(const LAS float*)(A_ + t * 528 + ch * 4), bv = *(const LAS float*)(B_ + t * 528 + ch * 4); Bc = av * Bc + bv; Ac *= av; }
      SEG[seg * 128 + ch] = (f32x2){Ac, Bc}; }
    __syncthreads();
    if (!FINAL) {
        if (seg == 0) { float A = 1.f, hh = 0.f;
#pragma unroll
            for (int s2 = 0; s2 < 4; ++s2) { const f32x2 c = SEG[s2 * 128 + ch]; hh = c.x * hh + c.y; A *= c.x; }
            CARRY[(size_t)(b * 16 + tc) * 1024 + n * 128 + ch] = make_float2(A, hh); }
    } else {
        float hh = 0.f;
        for (int j = 0; j < tc; ++j) { const float2 c = CARRY[(size_t)(b * 16 + j) * 1024 + n * 128 + ch]; hh = c.x * hh + c.y; }
        for (int s2 = 0; s2 < seg; ++s2) { const f32x2 c = SEG[s2 * 128 + ch]; hh = c.x * hh + c.y; }
        for (int t = seg * 32; t < seg * 32 + 32; ++t) { const float av = *(const LAS float*)(A_ + t * 528 + ch * 4), bv = *(const LAS float*)(B_ + t * 528 + ch * 4); hh = av * hh + bv;
            const float y = bf2f(U[(tok0 + t) * INC + C_LY + n * 128 + ch]); const float u3 = 0.7978845608028654f * (y + 0.044715f * y * y * y);
            const float ge = y * (1.f - 1.f / (1.f + __expf(2.f * u3)));
            BR2[(tok0 + t) * D + n * 128 + ch] = f2bf(hh * ge); }
    }
}

__device__ __forceinline__ void lru_seq_unit(kaptr_t ka, int l, const bf16_t* U, bf16_t* BR2, const bf16_t* LW, int unit, LAS unsigned char* lds, int tid, int lane, int wave) {
    const int q = unit & 3, n = (unit >> 2) & 7, b = unit >> 5;
    LAS unsigned char* Xc = lds;
    LAS unsigned char* Wq = lds + 34816;
    LAS float* A_T = (LAS float*)(lds + 52224);
    LAS float* B_T = (LAS float*)(lds + 69120);
    LAS unsigned char* Yr = lds + 86016;
    LAS f32x2* SEG = (LAS f32x2*)(lds + 93184);
    LAS float* HC = (LAS float*)(lds + 97280);
    LAS unsigned char* OUTS = lds + 94208;
    LAS unsigned char* Xr = lds + 105728;
    const int r32 = lane & 31, hi = lane >> 5, tt = wave & 3, mat = wave >> 2;
    const int chq = n * 128 + q * 32;
    const bf16_t* Ub = U + (size_t)b * S * INC;
    __syncthreads();
    { const int r = tid >> 4, ch = tid & 15;
#pragma unroll
      for (int i = 0; i < 2; ++i) { const int rr = r + 32 * i, mm = rr >> 5;
          const u32x4 v = *(const u32x4*)(LW + (size_t)(mm * 8 + n) * 16384 + (size_t)(q * 32 + (rr & 31)) * 128 + ch * 8); *(LAS u32x4*)(Wq + rr * 272 + ch * 16) = v; } }
    const int c16 = tid & 15, cc0 = n * 128 + c16 * 8;
    f32x4 cwv[4][2], cbv[2];
    { const float* cw = PIN(9) + (size_t)l * 4096 + cc0; const float* cb = PIN(10) + (size_t)l * 1024 + cc0; cbv[0] = *(const f32x4*)cb; cbv[1] = *(const f32x4*)(cb + 4);
#pragma unroll
      for (int j = 0; j < 4; ++j) { cwv[j][0] = *(const f32x4*)(cw + j * 1024); cwv[j][1] = *(const f32x4*)(cw + j * 1024 + 4); } }
    const int gch = l * 1024 + chq + r32;
    const float bgate = mat ? PIN(14)[gch] : PIN(12)[gch], sp = __logf(1.f + __expf(-PIN(15)[gch]));
    u32x4 pf[7], pfy;
#define LRU_FETCH(tcn) do { _Pragma("unroll") for (int i = 0; i < 7; ++i) { const int ts = (tcn) * 128 - 3 + 4 * (tid >> 4) + i; \
        pf[i] = (u32x4){0u, 0u, 0u, 0u}; if (ts >= 0) pf[i] = *(const u32x4*)(Ub + (size_t)ts * INC + C_LX + cc0); } \
        pfy = *(const u32x4*)(Ub + (size_t)((tcn) * 128 + (tid >> 2)) * INC + C_LY + chq + (tid & 3) * 8); } while (0)
    LRU_FETCH(0);
    float hc = 0.f;
#pragma unroll 1
    for (int tc = 0; tc < 16; ++tc) {
        if (tc > 0) { const int t = tid >> 2, c8 = tid & 3; *(u32x4*)(BR2 + ((size_t)b * S + (tc - 1) * 128 + t) * D + chq + c8 * 8) = *(const LAS u32x4*)(OUTS + t * 64 + c8 * 16); }
        *(LAS u32x4*)(Yr + (tid >> 2) * 64 + (tid & 3) * 16) = pfy;
#pragma unroll
        for (int i = 0; i < 4; ++i) { const int t = 4 * (tid >> 4) + i; f32x4 a0 = cbv[0], a1 = cbv[1];
#pragma unroll
            for (int j = 0; j < 4; ++j) { const u32x4 xv = pf[i + j];
                a0.x += cwv[j][0].x * bflo(xv.x); a0.y += cwv[j][0].y * bfhi(xv.x); a0.z += cwv[j][0].z * bflo(xv.y); a0.w += cwv[j][0].w * bfhi(xv.y);
                a1.x += cwv[j][1].x * bflo(xv.z); a1.y += cwv[j][1].y * bfhi(xv.z); a1.z += cwv[j][1].z * bflo(xv.w); a1.w += cwv[j][1].w * bfhi(xv.w); }
            u32x4 o; o.x = pk2(a0.x, a0.y); o.y = pk2(a0.z, a0.w); o.z = pk2(a1.x, a1.y); o.w = pk2(a1.z, a1.w);
            *(LAS u32x4*)(Xc + t * 272 + c16 * 16) = o; }
        __syncthreads();
        if (tc < 15) LRU_FETCH(tc + 1);
        { f32x16 acc = (f32x16){};
#pragma unroll
          for (int kk = 0; kk < 8; ++kk) { const bf16x8 a = *(const LAS bf16x8*)(Xc + (tt * 32 + r32) * 272 + (16 * kk + 8 * hi) * 2);
              const bf16x8 bw = *(const LAS bf16x8*)(Wq + (mat * 32 + r32) * 272 + (16 * kk + 8 * hi) * 2); acc = MFMA32(a, bw, acc); }
          if (mat == 0) {
#pragma unroll
              for (int g4 = 0; g4 < 4; ++g4) { f32x4 v;
#pragma unroll
                  for (int e = 0; e < 4; ++e) v[e] = __expf(-8.f * sigmoidf_(acc[4 * g4 + e] + bgate) * sp);
                  *(LAS f32x4*)(A_T + r32 * 132 + tt * 32 + 8 * g4 + 4 * hi) = v; }
          } else {
#pragma unroll
              for (int g4 = 0; g4 < 4; ++g4) { f32x4 v;
#pragma unroll
                  for (int e = 0; e < 4; ++e) { const int t = tt * 32 + 8 * g4 + 4 * hi + e; const float xc = bf2f(*(const LAS bf16_t*)(Xc + t * 272 + (q * 32 + r32) * 2)); v[e] = sigmoidf_(acc[4 * g4 + e] + bgate) * xc; }
                  *(LAS f32x4*)(B_T + r32 * 132 + tt * 32 + 8 * g4 + 4 * hi) = v; }
          } }
        __syncthreads();
        { const int chl = lane & 3, seg = lane >> 2, chw = wave * 4 + chl;
          const f32x4 a0 = *(const LAS f32x4*)(A_T + chw * 132 + seg * 8), a1 = *(const LAS f32x4*)(A_T + chw * 132 + seg * 8 + 4);
          const f32x4 g0 = *(const LAS f32x4*)(B_T + chw * 132 + seg * 8), g1 = *(const LAS f32x4*)(B_T + chw * 132 + seg * 8 + 4);
          float av[8] = {a0.x, a0.y, a0.z, a0.w, a1.x, a1.y, a1.z, a1.w}, bv[8] = {g0.x, g0.y, g0.z, g0.w, g1.x, g1.y, g1.z, g1.w};
          float Ac = 1.f, Bc = 0.f;
#pragma unroll
          for (int t = 0; t < 8; ++t) { bv[t] = sqrtf(fmaxf(1.f - av[t] * av[t], 0.f)) * bv[t]; Bc = av[t] * Bc + bv[t]; Ac *= av[t]; }
#pragma unroll
          for (int d = 4; d < 64; d <<= 1) { const float Ap = __shfl_up(Ac, d), Bp = __shfl_up(Bc, d); if (lane >= d) { Bc = Ac * Bp + Bc; Ac = Ac * Ap; } }
          float Ae = __shfl_up(Ac, 4), Be = __shfl_up(Bc, 4); if (lane < 4) { Ae = 1.f; Be = 0.f; }
          float hh = Ae * hc + Be;
#pragma unroll
          for (int t = 0; t < 8; ++t) { hh = av[t] * hh + bv[t]; const float y = bf2f(*(const LAS bf16_t*)(Yr + (seg * 8 + t) * 64 + chw * 2));
              const float ge = y * (1.f - __builtin_amdgcn_rcpf(1.f + __expf(1.5957691216057308f * (y + 0.044715f * y * y * y))));
              *(LAS bf16_t*)(OUTS + (seg * 8 + t) * 64 + chw * 2) = f2bf(hh * ge); }
          hc = __shfl(hh, 60 + chl); }
        __syncthreads();
    }
    { const int t = tid >> 2, c8 = tid & 3; *(u32x4*)(BR2 + ((size_t)b * S + 15 * 128 + t) * D + chq + c8 * 8) = *(const LAS u32x4*)(OUTS + t * 64 + c8 * 16); }
#undef LRU_FETCH
}

__device__ __forceinline__ void xattn_unit(const bf16_t* QX, const bf16_t* KX, const bf16_t* VXT, bf16_t* OX, int unit, LAS unsigned char* lds, int tid, int lane, int wave) {
    const int qb = unit & 7, h = (unit >> 3) & 3, b = unit >> 5;
    LAS unsigned char* Ks = lds; LAS unsigned char* Vt = lds + 69632; LAS float* wsf = (LAS float*)(lds + 137216) + wave * 32;
    const int r32 = lane & 31, hi = lane >> 5;
    __syncthreads();
    load_tile<256, 128>(Ks, 272, KX + (size_t)b * 256 * 512 + h * 128, 512, tid);
    load_tile<128, 256>(Vt, 528, VXT + (size_t)h * 128 * 2048 + b * 256, 2048, tid);
    const size_t q0 = (size_t)b * S + qb * 256 + wave * 32;
    bf16x8 qf[8];
#pragma unroll
    for (int kk = 0; kk < 8; ++kk) qf[kk] = *(const bf16x8*)(QX + (q0 + r32) * 512 + h * 128 + kk * 16 + hi * 8);
    __syncthreads();
    float mx = -INFINITY;
#pragma unroll 1
    for (int half = 0; half < 2; ++half) {
        const LAS unsigned char* kb = Ks + (half * 128 + r32) * 272 + 16 * hi;
#pragma unroll
        for (int k4 = 0; k4 < 4; ++k4) { f32x16 sc = (f32x16){};
#pragma unroll
            for (int kk = 0; kk < 8; ++kk) { const bf16x8 a = *(const LAS bf16x8*)(kb + k4 * 32 * 272 + 32 * kk); sc = MFMA32(a, qf[kk], sc); }
#pragma unroll
            for (int r = 0; r < 16; ++r) mx = fmaxf(mx, sc[r]);
            __builtin_amdgcn_sched_barrier(0); }
    }
    mx = fmaxf(mx, __shfl_xor(mx, 32));
    float sum = 0.f;
    f32x16 o[4];
#pragma unroll
    for (int d4 = 0; d4 < 4; ++d4) o[d4] = (f32x16){};
#pragma unroll 1
    for (int half = 0; half < 2; ++half) {
        const LAS unsigned char* kb = Ks + (half * 128 + r32) * 272 + 16 * hi;
        const LAS unsigned char* vb = Vt + r32 * 528 + (half * 128 + 4 * hi) * 2;
#pragma unroll
        for (int k4 = 0; k4 < 4; ++k4) { f32x16 sc = (f32x16){};
#pragma unroll
            for (int kk = 0; kk < 8; ++kk) { const bf16x8 a = *(const LAS bf16x8*)(kb + k4 * 32 * 272 + 32 * kk); sc = MFMA32(a, qf[kk], sc); }
#pragma unroll
            for (int r = 0; r < 16; ++r) { const float e = exp2f(sc[r] - mx); sc[r] = e; sum += e; }
#pragma unroll
            for (int s2 = 0; s2 < 2; ++s2) {
                u32x4 pw; pw.x = pk2(sc[8 * s2 + 0], sc[8 * s2 + 1]); pw.y = pk2(sc[8 * s2 + 2], sc[8 * s2 + 3]); pw.z = pk2(sc[8 * s2 + 4], sc[8 * s2 + 5]); pw.w = pk2(sc[8 * s2 + 6], sc[8 * s2 + 7]);
                const bf16x8 a = __builtin_bit_cast(bf16x8, pw);
#pragma unroll
                for (int d4 = 0; d4 < 4; ++d4) { const LAS unsigned char* vp = vb + d4 * 32 * 528 + (32 * k4 + 16 * s2) * 2;
                    const s16x4 lo = *(const LAS s16x4*)vp, hh = *(const LAS s16x4*)(vp + 16); o[d4] = MFMA32(a, cat8(lo, hh), o[d4]); } }
            __builtin_amdgcn_sched_barrier(0); }
    }
    sum += __shfl_xor(sum, 32);
    if (hi == 0) wsf[r32] = 1.f / sum;
    asm volatile("s_waitcnt lgkmcnt(0)" ::: "memory");
    __builtin_amdgcn_wave_barrier();
#pragma unroll
    for (int r = 0; r < 16; ++r) { const float rl = wsf[crow(r, hi)]; bf16_t* op = OX + (q0 + crow(r, hi)) * 512 + h * 128 + r32;
#pragma unroll
        for (int d4 = 0; d4 < 4; ++d4) op[d4 * 32] = f2bf(o[d4][r] * rl); }
}

#define XB_TMO      128
#define XB_XCNT(j)  (256  + 64 * (j))
#define XB_XSUB(j)  (1280 + 64 * (j))
#define XB_XGEN(j)  (2304 + 64 * (j))
#define XB_TOP      3328
#define XB_TOPGEN   3392
#define XCD_BAR_WORDS 3456
#define XB_SPIN_CAP (1u << 18)

__device__ __forceinline__ unsigned xb_ld(unsigned* p)              { return __hip_atomic_load(p, __ATOMIC_RELAXED, __HIP_MEMORY_SCOPE_AGENT); }
__device__ __forceinline__ unsigned xb_add(unsigned* p, unsigned v) { return __hip_atomic_fetch_add(p, v, __ATOMIC_RELAXED, __HIP_MEMORY_SCOPE_AGENT); }
__device__ __forceinline__ unsigned xb_xcc_id() { return (unsigned)__builtin_amdgcn_s_getreg((3 << 11) | 20) & 0xFu; }
#define XB_SPIN(cond, bar) do { unsigned _sp = 0; while (cond) { __builtin_amdgcn_s_sleep(1); \
    if ((++_sp & 255u) == 0u) { if (xb_ld(&(bar)[XB_TMO])) break; if (_sp > XB_SPIN_CAP) { atomicAdd(&(bar)[XB_TMO], 1u); break; } } } } while (0)

struct XcdBarrier {
    unsigned* bar; unsigned x;
    volatile LAS unsigned* st;
};

__device__ __forceinline__ XcdBarrier xcd_barrier_post(unsigned* bar, volatile LAS unsigned* st, int tid_) {
    XcdBarrier b; b.bar = bar; b.x = xb_xcc_id(); b.st = st;
    if (tid_ == 0) (void)xb_add(&bar[XB_XCNT(b.x)], 1u);
    return b;
}
__device__ __forceinline__ void xcd_barrier_complete(unsigned* bar, unsigned x, unsigned& nloc, unsigned& nx) {
    const unsigned G = gridDim.x * gridDim.y * gridDim.z;
    unsigned sum, cnt, mine, sp = 0u;
    for (;;) {
        sum = 0u; cnt = 0u; mine = 0u;
#pragma unroll
        for (unsigned j = 0; j < 16; ++j) { const unsigned c = xb_ld(&bar[XB_XCNT(j)]); sum += c; cnt += (c > 0u) ? 1u : 0u; mine = (j == x) ? c : mine; }
        if (sum == G) break;
        __builtin_amdgcn_s_sleep(1);
        if ((++sp & 255u) == 0u) { if (xb_ld(&bar[XB_TMO])) break; if (sp > XB_SPIN_CAP) { atomicAdd(&bar[XB_TMO], 1u); break; } }
    }
    nloc = mine > 0u ? mine : 1u; nx = cnt > 0u ? cnt : 1u;
}

__device__ __forceinline__ void xcd_barrier(const XcdBarrier& b, int tid_) {
    asm volatile("s_waitcnt vmcnt(0)" ::: "memory");
    __syncthreads();
    if (tid_ == 0) {
        unsigned* bar = b.bar;
        __builtin_amdgcn_s_waitcnt(0);
        unsigned nloc = b.st[0], nx = b.st[1];
        if (nloc == 0u) { xcd_barrier_complete(bar, b.x, nloc, nx); b.st[0] = nloc; b.st[1] = nx; }
        const unsigned old = xb_add(&bar[XB_XSUB(b.x)], 1u);
        const unsigned gen = old / nloc;
        if (old + 1u == (gen + 1u) * nloc) {
            __builtin_amdgcn_fence(__ATOMIC_RELEASE, "agent");
            asm volatile("s_waitcnt vmcnt(0)" ::: "memory");
            const unsigned og = xb_add(&bar[XB_TOP], 1u);
            const unsigned tg = og / nx;
            if (og + 1u == (tg + 1u) * nx) xb_add(&bar[XB_TOPGEN], 1u);
            else XB_SPIN(xb_ld(&bar[XB_TOPGEN]) == tg, bar);
            __builtin_amdgcn_fence(__ATOMIC_ACQUIRE, "agent");
            xb_add(&bar[XB_XGEN(b.x)], 1u);
            asm volatile("s_waitcnt vmcnt(0)" ::: "memory");
        } else {
            XB_SPIN(xb_ld(&bar[XB_XGEN(b.x)]) == gen, bar);
            __builtin_amdgcn_fence(__ATOMIC_ACQUIRE, "agent");
            asm volatile("s_waitcnt vmcnt(0)" ::: "memory");
        }
    }
    __syncthreads();
}

#define XL_RANK(j) (8192 + 64 * (j))
#define XL_SUB(j)  (9216 + 64 * (j))
#define XL_GEN(j)  (10240 + 64 * (j))
__device__ __forceinline__ void xcd_local_barrier(unsigned* bar, unsigned x, int tid_) {
    asm volatile("s_waitcnt vmcnt(0)" ::: "memory");
    __syncthreads();
    if (tid_ == 0) {
        __builtin_amdgcn_s_waitcnt(0);
        const unsigned old = xb_add(&bar[XL_SUB(x)], 1u), gen = old >> 5;
        if ((old & 31u) == 31u) xb_add(&bar[XL_GEN(x)], 1u);
        else XB_SPIN(xb_ld(&bar[XL_GEN(x)]) == gen, bar);
        __builtin_amdgcn_fence(__ATOMIC_ACQUIRE, "agent");
        asm volatile("s_waitcnt vmcnt(0)" ::: "memory");
    }
    __syncthreads();
}

#define PH_BEGIN KA_GET(ka) int tid = tid_of(wave_s), G = gridDim.x, bx = bxv; GAS1 unsigned char* ws = PWS; asm volatile("" : "+s"(G), "+s"(bx), "+s"(ws)); \
    const int lane = tid & 63, wave = __builtin_amdgcn_readfirstlane(tid >> 6), vc = lok ? (bx & 7) * 32 + (bx >> 3) : bx; (void)lane; (void)wave; (void)vc;
#ifndef DUP_SYNC
#define DUP_SYNC 1
#endif
#ifndef DUP_P0
#define DUP_P0 1
#endif
#ifndef DUP_2A
#define DUP_2A 1
#endif
#ifndef DUP_AT
#define DUP_AT 1
#endif
#ifndef DUP_2B
#define DUP_2B 1
#endif
#ifndef DUP_G1
#define DUP_G1 1
#endif
#ifndef DUP_G3
#define DUP_G3 1
#endif
#ifndef DUP_G5
#define DUP_G5 1
#endif
#ifndef DUP_G8
#define DUP_G8 1
#endif
#ifndef DUP_LRU
#define DUP_LRU 1
#endif
#ifndef DUP_G4
#define DUP_G4 1
#endif
#ifndef DUP_G9
#define DUP_G9 1
#endif
#ifndef DUP_XA
#define DUP_XA 1
#endif
#define GSYNC() do { for (int q_ = 0; q_ < DUP_SYNC; ++q_) xcd_barrier(xbar, tid_of(wave_s)); } while (0)
#define LSYNC() do { if (lok) xcd_local_barrier(xbar.bar, xbar.x, tid_of(wave_s)); else xcd_barrier(xbar, tid_of(wave_s)); } while (0)
__global__ void __launch_bounds__(512, 2) fwd_megakernel(Params p) {
    extern __shared__ __attribute__((aligned(16))) unsigned char lds[];
    cg::grid_group grid = cg::this_grid();
    LAS unsigned char* L = (LAS unsigned char*)lds;
    const int wave_s = __builtin_amdgcn_readfirstlane(threadIdx.x >> 6);
    XcdBarrier xbar;
    { KA_GET(ka) volatile LAS unsigned* MISC = (volatile LAS unsigned*)(L + MISC_OFF); const int t0 = tid_of(wave_s);
      if (t0 < 2) MISC[t0] = 0u;
      __syncthreads();
      xbar = xcd_barrier_post((unsigned*)(GAS1 unsigned*)(PWS + 16384), MISC, t0);
      if (t0 == 0) MISC[2] = xb_add(&xbar.bar[XL_RANK(xbar.x)], 1u);
      __syncthreads(); }
    int bxv = blockIdx.x; unsigned lok = 0u;
    { PH_BEGIN
        const int gw = bx * 8 + wave, NGW = G * 8;
        {
                float* slots = WSP(float, WS_SLOT); float* rsm = WSP(float, WS_RSM); float* tab = WSP(float, WS_TAB);
                for (int m = gw; m < M; m += 2 * NGW) {
                    const int m2 = m + NGW; const f32x4* x0 = (const f32x4*)(PIN(0) + (size_t)m * D) + lane; const f32x4* x1 = (const f32x4*)(PIN(0) + (size_t)m2 * D) + lane; f32x4 a[4], b[4]; float s0 = 0.f, s1 = 0.f;
#pragma unroll
                    for (int j = 0; j < 4; ++j) { a[j] = x0[64 * j]; b[j] = x1[64 * j]; }
                    u32x2* o0 = (u32x2*)(WSP(bf16_t, WS_XB) + (size_t)m * D) + lane; u32x2* o1 = (u32x2*)(WSP(bf16_t, WS_XB) + (size_t)m2 * D) + lane;
#pragma unroll
                    for (int j = 0; j < 4; ++j) { s0 += (a[j].x * a[j].x + a[j].y * a[j].y) + (a[j].z * a[j].z + a[j].w * a[j].w); s1 += (b[j].x * b[j].x + b[j].y * b[j].y) + (b[j].z * b[j].z + b[j].w * b[j].w);
                        u32x2 w; w.x = pk2(a[j].x, a[j].y); w.y = pk2(a[j].z, a[j].w); o0[64 * j] = w; w.x = pk2(b[j].x, b[j].y); w.y = pk2(b[j].z, b[j].w); o1[64 * j] = w; }
                    s0 = wave_sum(s0); s1 = wave_sum(s1);
                    if (lane < 16) { slots[(size_t)m * 16 + lane] = lane == 0 ? s0 : 0.f; slots[(size_t)m2 * 16 + lane] = lane == 0 ? s1 : 0.f; } }
                for (int m = gw; m < MM; m += NGW) { const float ss = row_to_bf16(PIN(1) + (size_t)m * D, WSP(bf16_t, WS_MEMB) + (size_t)m * D, lane); if (lane == 0) rsm[m] = rsqrtf(ss * (1.f / 1024.f) + 1e-6f); }
                for (int idx = bx * 512 + tid; idx < 2048 * 64; idx += G * 512) { const int pos = idx >> 6, i = idx & 63;
                    const float theta = 1.f / powf(10000.f, (float)i / 63.f), ph = (float)pos * theta;
                    const float k = rintf(ph * 0.15915494309189535f); float r = fmaf(-k, 6.28125f, ph); r = fmaf(-k, 1.9353071795864769e-3f, r);
                    tab[2 * idx] = __cosf(r); tab[2 * idx + 1] = __sinf(r); }
            }
        LAS float* scr = (LAS float*)(L + wave * 16896);
        conv_set(ka, ws, 0, 0, gw, NGW, scr, lane); conv_set(ka, ws, 0, 1, gw, NGW, scr, lane);
        }
    if (gridDim.x == 0x7fffffffu) grid.sync();
    xcd_barrier(xbar, tid_of(wave_s));
    { volatile LAS unsigned* MISC = (volatile LAS unsigned*)(L + MISC_OFF); const int t0 = tid_of(wave_s);
      if (t0 == 0) { unsigned ok = gridDim.x == 256u ? 1u : 0u;
#pragma unroll
          for (unsigned j = 0; j < 8; ++j) ok &= (xb_ld(&xbar.bar[XL_RANK(j)]) == 32u) ? 1u : 0u;
          MISC[3] = ok; }
      __syncthreads();
      lok = (unsigned)__builtin_amdgcn_readfirstlane((int)MISC[3]);
      if (lok) bxv = (int)xbar.x + 8 * __builtin_amdgcn_readfirstlane((int)MISC[2]); }
#pragma unroll 1
    for (int l = 0; l < DEPTH; ++l) {
#ifndef SKIP_G1
        for (int dup_ = 0; dup_ < DUP_G1; ++dup_) { PH_BEGIN SchedStd Sd{(const char*)WSP(bf16_t, WS_XB), (const char*)WSP(char, WS_WIN), 64, 44, 1024, G, bx, (size_t)8 * 512 * 1024, 1};
          Unit u0; int pm0 = -1; if (Sd.next(0, u0)) pm0 = u0.pm & ~4; LAS float* rsl = (LAS float*)(L + 131072);
          if (pm0 >= 0) rsl[tid] = slot_rstd(WSP(float, WS_SLOT), (pm0 + 4 * (tid >> 8)) * 256 + (tid & 255));
          __syncthreads();
          EpiWin E{WSP(bf16_t, WS_U), WSP(bf16_t, WS_QKVC), WSP(float, WS_SLOT), WSP(float, WS_TAB), rsl, pm0};
          pg8::gemm_phase<EpiWin, SchedStd, true, true>(L, tid, pg8::Gemm{1024}, Sd, E); }
#endif
        GSYNC();
#ifndef SKIP_RS
        for (int dup_ = 0; dup_ < DUP_2A; ++dup_) { PH_BEGIN
          const int slot = bx >> 3, rs_u = lok ? (slot < 16 ? (bx & 7) * 16 + slot : -1) : (bx < 128 ? bx : -1), cv_i = lok ? (slot >= 16 ? (bx & 7) * 16 + slot - 16 : -1) : (bx >= 128 ? bx - 128 : -1);
          if (rs_u >= 0) ret_state_unit(WSP(bf16_t, WS_U), WSP(bf16_t, WS_RETST), rs_u, L, tid, lane, wave);
          if (l + 1 < DEPTH && cv_i >= 0) conv_set(ka, ws, l + 1, 0, cv_i * 8 + wave, 1024, (LAS float*)(L + wave * 16896), lane);
          __syncthreads(); }
#endif
        LSYNC();
#ifndef SKIP_L2
        for (int dup_ = 0; dup_ < DUP_LRU; ++dup_) { PH_BEGIN
#pragma unroll 1
          for (int u = vc; u < 256; u += G) lru_seq_unit(ka, l, WSP(bf16_t, WS_U), WSP(bf16_t, WS_BR) + (size_t)2 * M * D, WSP(bf16_t, WS_LRUW), u, L, tid, lane, wave); }
#endif
        __syncthreads();
#ifndef SKIP_RO
        for (int dup_ = 0; dup_ < DUP_2B; ++dup_) { PH_BEGIN
#pragma unroll 1
          for (int u = 2 * vc; u < 2 * vc + 2; ++u) ret_out_unit(WSP(bf16_t, WS_U), WSP(bf16_t, WS_RETST), WSP(bf16_t, WS_BR) + (size_t)M * D, u, L, tid, lane, wave); }
#endif
        __syncthreads();
#ifndef SKIP_AT
        for (int dup_ = 0; dup_ < DUP_AT; ++dup_) {
#pragma unroll 1
            for (int it = 0;; ++it) {
                { KA_GET(ka) int G = gridDim.x, bx = bxv; GAS1 unsigned char* ws = PWS; asm volatile("" : "+s"(G), "+s"(bx), "+s"(ws));
                  const int vc = lok ? (bx & 7) * 32 + (bx >> 3) : bx, pr = vc + (it >> 3) * G; if (pr >= 256) break;
                  const int bh = pr >> 2, s4 = pr & 3, b = bh >> 3, h = bh & 7, qb = (it & 4) ? s4 : 7 - s4, j = it & 3, c = j >> 1, vh = j & 1; const bf16_t* Qc = WSP(bf16_t, WS_QKVC);
                  const size_t pl = (size_t)2048 * 64, sel = (size_t)M * 1024;
                  attn_body::attn_unit<8>(0, 0, qb, (const attn_body::bf16*)(Qc + (size_t)(bh * 2 + c) * pl), (const attn_body::bf16*)(Qc + sel + (size_t)(bh * 2 + c) * pl),
                                          (const attn_body::bf16*)(Qc + 2 * sel + (size_t)(bh * 2 + vh) * pl), (attn_body::bf16*)(WSP(bf16_t, WS_OD4) + (size_t)b * S * 2048 + h * 256 + j * 64), (char*)lds, tid_of(wave_s)); }
                if ((it & 3) == 3) {
                    asm volatile("s_waitcnt vmcnt(0)" ::: "memory");
                    KA_GET(ka) int it2 = it, G = gridDim.x, bx = bxv, t2 = tid_of(wave_s); GAS1 unsigned char* ws = PWS; asm volatile("" : "+s"(it2), "+s"(G), "+s"(bx), "+s"(ws));
                    const int vc = lok ? (bx & 7) * 32 + (bx >> 3) : bx, pr = vc + (it2 >> 3) * G, bh = pr >> 2, s4 = pr & 3, b = bh >> 3, h = bh & 7, qb = (it2 & 4) ? s4 : 7 - s4;
                    const int ln = t2 & 63, wv = t2 >> 6;
                    const float lam_init = 0.8f - 0.6f * (l == 0 ? 1.f : l == 1 ? 0.7408182206817179f : l == 2 ? 0.5488116360940264f : 0.4065696597405991f);
                    float lam;
                    { const float a = PIN(4)[l * 64 + ln] * PIN(5)[l * 64 + ln], c = PIN(6)[l * 64 + ln] * PIN(7)[l * 64 + ln]; lam = __expf(wave_sum(a)) - __expf(wave_sum(c)) + lam_init; }
                    const float g0 = PIN(8)[l * 128 + 2 * ln] * (1.f - lam_init), g1 = PIN(8)[l * 128 + 2 * ln + 1] * (1.f - lam_init);
                    const size_t row0 = (size_t)b * S + qb * 256 + wv * 32; const int vh = ln >> 5, cw = ln & 31;
                    bf16_t* OD4 = WSP(bf16_t, WS_OD4); bf16_t* BR = WSP(bf16_t, WS_BR);
#pragma unroll 1
                    for (int r0 = 0; r0 < 32; r0 += 16) {
                        unsigned av[16], cv[16];
#pragma unroll
                        for (int rr = 0; rr < 16; ++rr) { unsigned* o4 = (unsigned*)(OD4 + (row0 + r0 + rr) * 2048 + h * 256);
                            av[rr] = __hip_atomic_load(o4 + vh * 32 + cw, __ATOMIC_RELAXED, __HIP_MEMORY_SCOPE_AGENT); cv[rr] = __hip_atomic_load(o4 + (2 + vh) * 32 + cw, __ATOMIC_RELAXED, __HIP_MEMORY_SCOPE_AGENT); }
                        float d0v[16], d1v[16], ssv[16];
#pragma unroll
                        for (int rr = 0; rr < 16; ++rr) { d0v[rr] = bflo(av[rr]) - lam * bflo(cv[rr]); d1v[rr] = bfhi(av[rr]) - lam * bfhi(cv[rr]); ssv[rr] = d0v[rr] * d0v[rr] + d1v[rr] * d1v[rr]; }
#pragma unroll
                        for (int o = 1; o < 64; o <<= 1) {
#pragma unroll
                            for (int rr = 0; rr < 16; ++rr) ssv[rr] += __shfl_xor(ssv[rr], o); }
#pragma unroll
                        for (int rr = 0; rr < 16; ++rr) { const float rstd = rsqrtf(ssv[rr] * (1.f / 128.f) + 1e-5f);
                            *(unsigned*)(BR + (row0 + r0 + rr) * D + h * 128 + 2 * ln) = pk2(d0v[rr] * rstd * g0, d1v[rr] * rstd * g1); } }
                }
            }
        }
#endif
        LSYNC();
#ifndef SKIP_G3
        for (int dup_ = 0; dup_ < DUP_G3; ++dup_) { PH_BEGIN SchedBranch Sd{(const char*)WSP(bf16_t, WS_BR), (const char*)WSP(char, WS_WBR), G, bx}; EpiBranch E{WSP(bf16_t, WS_U), WSP(bf16_t, WS_MERGED)};
          pg8::gemm_phase<EpiBranch, SchedBranch, true, true>(L, tid, pg8::Gemm{1024}, Sd, E); }
#endif
        LSYNC();
#ifndef SKIP_G4
        for (int dup_ = 0; dup_ < (l == 0 ? DUP_G4 : 1); ++dup_) { PH_BEGIN SchedStd Sd{(const char*)WSP(bf16_t, WS_MERGED), (const char*)WSP(char, WS_WOUT), 64, 4, 1024, G, bx, MBS * 2}; EpiResid E{l == 0 ? PIN(0) : POUT, POUT, WSP(bf16_t, WS_XB), WSP(float, WS_SLOT)};
          pg8::gemm_phase<EpiResid, SchedStd, true, true>(L, tid, pg8::Gemm{1024}, Sd, E); }
#endif
        LSYNC();
#ifndef SKIP_G5
        for (int dup_ = 0; dup_ < DUP_G5; ++dup_) { PH_BEGIN SchedXA Sd{(const char*)WSP(bf16_t, WS_XB), (const char*)WSP(bf16_t, WS_MEMB), (const char*)WSP(char, WS_WQ), (const char*)WSP(char, WS_WKV), G, bx};
          LAS float* rsl = (LAS float*)(L + 131072); { Unit u0; if (Sd.next(0, u0) && u0.aux == 0 && tid < 256) rsl[tid] = slot_rstd(WSP(float, WS_SLOT), u0.pm * 256 + tid); }
          __syncthreads();
          EpiXA E{WSP(bf16_t, WS_QX), WSP(bf16_t, WS_KX), WSP(bf16_t, WS_VXT), WSP(float, WS_SLOT), WSP(float, WS_RSM), rsl};
          pg8::gemm_phase<EpiXA, SchedXA, true, true>(L, tid, pg8::Gemm{1024}, Sd, E);
          if (bx >= 160) conv_set(ka, ws, l, 2, (bx - 160) * 8 + wave, (G - 160) * 8, (LAS float*)(L + wave * 16896), lane); }
#endif
        GSYNC();
#ifndef SKIP_XA
        for (int dup_ = 0; dup_ < DUP_XA; ++dup_) { PH_BEGIN
#pragma unroll 1
          for (int u = vc; u < 256; u += G) xattn_unit(WSP(bf16_t, WS_QX), WSP(bf16_t, WS_KX), WSP(bf16_t, WS_VXT), WSP(bf16_t, WS_OX), u, L, tid, lane, wave);
          __syncthreads();
          if (l + 1 < DEPTH) conv_set(ka, ws, l + 1, 1, bx * 8 + wave, G * 8, (LAS float*)(L + wave * 16896), lane); }
#endif
        LSYNC();
#ifndef SKIP_G7
        { PH_BEGIN SchedStd Sd{(const char*)WSP(bf16_t, WS_OX), (const char*)WSP(char, WS_WO), 64, 4, 512, G, bx, (size_t)8 * 512 * 512}; EpiResid E{POUT, POUT, WSP(bf16_t, WS_XB), WSP(float, WS_SLOT)};
          pg8::gemm_phase<EpiResid, SchedStd, true, true>(L, tid, pg8::Gemm{512}, Sd, E); }
#endif
        LSYNC();
#ifndef SKIP_G8
        for (int dup_ = 0; dup_ < DUP_G8; ++dup_) { PH_BEGIN SchedStd Sd{(const char*)WSP(bf16_t, WS_XB), (const char*)WSP(char, WS_W1), 64, 16, 1024, G, bx, (size_t)8 * 512 * 1024, 1};
          Unit u0; int pm0 = -1; if (Sd.next(0, u0)) pm0 = u0.pm & ~4; LAS float* rsl = (LAS float*)(L + 131072);
          if (pm0 >= 0) rsl[tid] = slot_rstd(WSP(float, WS_SLOT), (pm0 + 4 * (tid >> 8)) * 256 + (tid & 255));
          __syncthreads();
          EpiW1 E{WSP(bf16_t, WS_H), WSP(float, WS_SLOT), rsl, pm0};
          pg8::gemm_phase<EpiW1, SchedStd, true, true>(L, tid, pg8::Gemm{1024}, Sd, E); }
#endif
        LSYNC();
#ifndef SKIP_G9
        for (int dup_ = 0; dup_ < DUP_G9; ++dup_) { PH_BEGIN SchedStd Sd{(const char*)WSP(bf16_t, WS_H), (const char*)WSP(char, WS_W2), 64, 4, 4096, G, bx, UBS * 2}; EpiResid E{POUT, dup_ + 1 < DUP_G9 ? WSP(float, WS_QX) : POUT, WSP(bf16_t, WS_XB), WSP(float, WS_SLOT)};
          pg8::gemm_phase<EpiResid, SchedStd, true, true>(L, tid, pg8::Gemm{4096}, Sd, E); }
#endif
        LSYNC();
    }
    { PH_BEGIN const float* slots = WSP(float, WS_SLOT); float* out = POUT;
      const int m0 = lok ? (bx & 7) * 2048 + (bx >> 3) * 8 + wave : bx * 8 + wave, mstep = lok ? 256 : G * 8, mend = lok ? ((bx & 7) + 1) * 2048 : M;
      const f32x4* gr = (const f32x4*)PIN(26) + lane; f32x4 gv[4];
#pragma unroll
      for (int j = 0; j < 4; ++j) gv[j] = gr[64 * j];
      for (int m = m0; m < mend; m += 2 * mstep) { const int m2 = m + mstep;
        const float rs0 = slot_rstd(slots, m), rs1 = slot_rstd(slots, m2); f32x4* x0 = (f32x4*)(out + (size_t)m * D) + lane; f32x4* x1 = (f32x4*)(out + (size_t)m2 * D) + lane; f32x4 a[4], b[4];
#pragma unroll
        for (int j = 0; j < 4; ++j) { a[j] = x0[64 * j]; b[j] = x1[64 * j]; }
#pragma unroll
        for (int j = 0; j < 4; ++j) { x0[64 * j] = a[j] * rs0 * gv[j]; x1[64 * j] = b[j] * rs1 * gv[j]; } } }
}

extern "C" void kernel_launch(void* const* d_in, const int* in_sizes, int n_in, void* d_out, int out_size, void* d_ws, size_t ws_size, hipStream_t stream) {
    static int grid = 0;
    if (grid == 0) {
        if (n_in != 27 || out_size != M * D || ws_size < WS_END) { fprintf(stderr, "kernel_launch: unexpected shapes (n_in %d, out %d, ws %zu)\n", n_in, out_size, ws_size); grid = -1; return; }
        int dev = 0, cus = 0, per_cu = 0;
        hipGetDevice(&dev); hipDeviceGetAttribute(&cus, hipDeviceAttributeMultiprocessorCount, dev);
        hipFuncSetAttribute((const void*)fwd_megakernel, hipFuncAttributeMaxDynamicSharedMemorySize, LDS_BYTES);
        hipOccupancyMaxActiveBlocksPerMultiprocessor(&per_cu, (const void*)fwd_megakernel, 512, LDS_BYTES);
        if (per_cu < 1) per_cu = 1;
        (void)hipGetLastError();
        grid = cus * per_cu; if (grid > 256) grid = 256;
        if (grid != 256) { fprintf(stderr, "kernel_launch: needs a 256-workgroup cooperative grid, got %d\n", grid); grid = -1; return; }
    }
    if (grid < 0) return;
    Params p{};
    for (int i = 0; i < 27; ++i) p.in[i] = (const float*)d_in[i];
    p.out = (float*)d_out; p.ws = (unsigned char*)d_ws;
    if (hipMemsetAsync(d_ws, 0, 65536, stream) != hipSuccess) { fprintf(stderr, "memset failed\n"); return; }
    void* args[] = {&p};
    hipError_t e = hipLaunchCooperativeKernel((void*)fwd_megakernel, dim3(grid), dim3(512), args, LDS_BYTES, stream);
    if (e != hipSuccess) fprintf(stderr, "cooperative launch failed: %s (grid %d)\n", hipGetErrorString(e), grid);
}
```
